# Optimizing an MI355X kernel written in HIP

```python
import jax, jax.numpy as jnp
from jax import lax
import numpy as np

D_MODEL = 1024
BATCH = 2
SEQ = 16384
DEPTH = 2

POOL_WIDTH = D_MODEL // 2
N_POOL_GROUPS = 4
POOL_GROUP_DIM = POOL_WIDTH // N_POOL_GROUPS
POOL_WINDOWS = (2, 4, 8, 16)
HGRN_WIDTH = D_MODEL // 2
HGRN_EXPAND = 128
HGRN_HEADS = HGRN_WIDTH // HGRN_EXPAND
HGRN_HK = HGRN_HEADS * HGRN_EXPAND
HGRN_HEAD_V = HGRN_WIDTH // HGRN_HEADS
CHUNK = 64
N_BRANCHES = 2
OFF_Q = POOL_WIDTH
OFF_F = OFF_Q + HGRN_HK
OFF_I = OFF_F + HGRN_HK
OFF_G = OFF_I + HGRN_WIDTH
OFF_GATES = OFF_G + HGRN_WIDTH
IN_COLS = OFF_GATES + N_BRANCHES * D_MODEL
D_FF_DENSE = 2816
N_EXPERTS = 8
TOP_K = 2
D_FF_EXPERT = 3584
N_DENSE = (DEPTH + 1) // 2
N_MOE = DEPTH // 2
EPS = 1e-6
LB_FLOOR = 1e-30

kernel_name = "hybrid_pool_hgrn2_gated_moe_trunk"


def _rmsnorm(x, w):
    xf = x.astype(jnp.float32)
    y = xf * lax.rsqrt(jnp.mean(xf * xf, axis=-1, keepdims=True) + EPS)
    return (y * w.astype(jnp.float32)).astype(x.dtype)


def _swiglu(h, w_gate, w_up, w_down):
    return (jax.nn.silu(h @ w_gate) * (h @ w_up)) @ w_down


def _pool_mixer(u, pool_w, pool_scale):
    B, S, _ = u.shape
    ug = u.reshape(B, S, N_POOL_GROUPS, POOL_GROUP_DIM).astype(jnp.float32)
    csum = jnp.cumsum(ug, axis=1)
    pos = jnp.arange(1, S + 1, dtype=jnp.float32)[None, :, None]
    outs = []
    for gi, w in enumerate(POOL_WINDOWS):
        c = csum[:, :, gi]
        c_prev = jnp.pad(c, ((0, 0), (w, 0), (0, 0)))[:, :S]
        outs.append((c - c_prev) / jnp.minimum(pos, float(w)))
    pooled = (jnp.stack(outs, axis=2) - ug).astype(u.dtype)
    mixed = jnp.einsum('bsgc,gcd->bsgd', pooled, pool_w)
    return mixed.reshape(B, S, POOL_WIDTH) * pool_scale


def _hgrn2_chunked(q, k, v, log_f):
    B, S, H, dk = q.shape
    dv = v.shape[-1]
    n_chunks = S // CHUNK

    def to_chunks(t):
        return t.reshape(B, n_chunks, CHUNK, H, t.shape[-1]).transpose(1, 0, 3, 2, 4)

    qc, kc, vc = to_chunks(q), to_chunks(k), to_chunks(v)
    G = jnp.cumsum(to_chunks(log_f), axis=3)
    mask = jnp.tril(jnp.ones((CHUNK, CHUNK), dtype=bool))[:, :, None]

    def step(state, xs):
        qb, kb, vb, Gb = xs
        diff = Gb[:, :, :, None, :] - Gb[:, :, None, :, :]
        decay = jnp.where(mask, jnp.exp(jnp.where(mask, diff, 0.0)), 0.0)
        scores = jnp.einsum('bhtk,bhsk,bhtsk->bhts', qb, kb, decay)
        o = jnp.einsum('bhts,bhsv->bhtv', scores, vb) + jnp.einsum('bhtk,bhkv->bhtv', qb * jnp.exp(Gb), state)
        G_last = Gb[:, :, -1:, :]
        new_state = jnp.exp(G_last[:, :, 0, :])[..., None] * state + jnp.einsum(
            'bhsk,bhsv->bhkv', kb * jnp.exp(G_last - Gb), vb)
        return new_state, o

    state0 = jnp.zeros((B, H, dk, dv), jnp.float32)
    _, o = lax.scan(step, state0, (qc, kc, vc, G))
    return o.transpose(1, 0, 3, 2, 4).reshape(B, S, H, dv)


def _hgrn2_mixer(q_pre, f_pre, i_pre, g_pre, lb, norm_w):
    B, S, _ = q_pre.shape
    f32 = jnp.float32
    q = jax.nn.silu(q_pre.astype(f32)).reshape(B, S, HGRN_HEADS, HGRN_EXPAND)
    log_lb = jnp.log(jnp.maximum(lb, LB_FLOOR))
    log_f = jnp.logaddexp(log_lb, jnp.log1p(-lb) + jax.nn.log_sigmoid(f_pre.astype(f32)))
    k = -jnp.expm1(log_f)
    log_f = log_f.reshape(B, S, HGRN_HEADS, HGRN_EXPAND)
    k = k.reshape(B, S, HGRN_HEADS, HGRN_EXPAND)
    v = i_pre.astype(f32).reshape(B, S, HGRN_HEADS, HGRN_HEAD_V)
    o = _hgrn2_chunked(q, k, v, log_f)
    o = o * lax.rsqrt(jnp.mean(o * o, axis=-1, keepdims=True) + EPS) * norm_w.astype(f32)
    g = jax.nn.silu(g_pre.astype(f32)).reshape(B, S, HGRN_HEADS, HGRN_HEAD_V)
    return (o * g).reshape(B, S, HGRN_WIDTH).astype(q_pre.dtype)


def _token_mixer(h, w_in, gate_bias, pool_w, pool_scale, pool_up, lb, hgrn_norm_w, hgrn_up, w_out):
    proj = h @ w_in
    u = proj[..., :OFF_Q]
    q_pre = proj[..., OFF_Q:OFF_F]
    f_pre = proj[..., OFF_F:OFF_I]
    i_pre = proj[..., OFF_I:OFF_G]
    g_pre = proj[..., OFF_G:OFF_GATES]
    gates = jax.nn.sigmoid(proj[..., OFF_GATES:] + gate_bias)
    y_pool = _pool_mixer(u, pool_w, pool_scale) @ pool_up
    y_hgrn = _hgrn2_mixer(q_pre, f_pre, i_pre, g_pre, lb, hgrn_norm_w) @ hgrn_up
    merged = gates[..., :D_MODEL] * y_pool + gates[..., D_MODEL:] * y_hgrn
    return merged @ w_out


def _moe(h, router, w_gate, w_up, w_down):
    logits = (h @ router).astype(jnp.float32)
    top_v, top_i = lax.top_k(logits, TOP_K)
    top_w = jax.nn.softmax(top_v, axis=-1)
    combine = jnp.sum(jax.nn.one_hot(top_i, N_EXPERTS, dtype=jnp.float32) * top_w[..., None], axis=-2)
    y = jnp.zeros_like(h)
    for e in range(N_EXPERTS):
        y = y + combine[..., e:e + 1].astype(h.dtype) * _swiglu(h, w_gate[e], w_up[e], w_down[e])
    return y


def setup_inputs(seed: int = 0) -> dict:
    key = jax.random.key(seed)
    ks = jax.random.split(key, 24)
    f32 = jnp.float32

    def w(k, shape, fan_in):
        return jax.random.normal(k, shape, f32) * (fan_in ** -0.5)

    def gain(k, shape):
        return 1.0 + 0.05 * jax.random.normal(k, shape, f32)

    return {
        "x": jax.random.normal(ks[0], (BATCH, SEQ, D_MODEL), f32),
        "attn_norm_w": gain(ks[1], (DEPTH, D_MODEL)),
        "w_in": w(ks[2], (DEPTH, D_MODEL, IN_COLS), D_MODEL),
        "gate_bias": 0.01 * jax.random.normal(ks[3], (DEPTH, N_BRANCHES * D_MODEL), f32),
        "pool_w": w(ks[4], (DEPTH, N_POOL_GROUPS, POOL_GROUP_DIM, POOL_GROUP_DIM), POOL_GROUP_DIM),
        "pool_scale": gain(ks[5], (DEPTH, POOL_WIDTH)),
        "pool_up": w(ks[6], (DEPTH, POOL_WIDTH, D_MODEL), POOL_WIDTH),
        "hgrn_lower_bounds": 0.5 * jax.random.normal(ks[7], (DEPTH, HGRN_HK), f32),
        "hgrn_norm_w": gain(ks[8], (DEPTH, HGRN_HEAD_V)),
        "hgrn_up": w(ks[9], (DEPTH, HGRN_WIDTH, D_MODEL), HGRN_WIDTH),
        "w_out": w(ks[10], (DEPTH, D_MODEL, D_MODEL), D_MODEL),
        "ffn_norm_w": gain(ks[11], (DEPTH, D_MODEL)),
        "dense_w_gate": w(ks[12], (N_DENSE, D_MODEL, D_FF_DENSE), D_MODEL),
        "dense_w_up": w(ks[13], (N_DENSE, D_MODEL, D_FF_DENSE), D_MODEL),
        "dense_w_down": w(ks[14], (N_DENSE, D_FF_DENSE, D_MODEL), D_FF_DENSE),
        "moe_router": w(ks[15], (N_MOE, D_MODEL, N_EXPERTS), D_MODEL),
        "moe_w_gate": w(ks[16], (N_MOE, N_EXPERTS, D_MODEL, D_FF_EXPERT), D_MODEL),
        "moe_w_up": w(ks[17], (N_MOE, N_EXPERTS, D_MODEL, D_FF_EXPERT), D_MODEL),
        "moe_w_down": w(ks[18], (N_MOE, N_EXPERTS, D_FF_EXPERT, D_MODEL), D_FF_EXPERT),
        "final_norm_w": gain(ks[19], (D_MODEL,)),
    }


def reference(x, attn_norm_w, w_in, gate_bias, pool_w, pool_scale, pool_up, hgrn_lower_bounds,
              hgrn_norm_w, hgrn_up, w_out, ffn_norm_w, dense_w_gate, dense_w_up, dense_w_down,
              moe_router, moe_w_gate, moe_w_up, moe_w_down, final_norm_w):
    lb_soft = jax.nn.softmax(hgrn_lower_bounds.astype(jnp.float32), axis=0)
    lower_bounds = jnp.clip(jnp.cumsum(lb_soft, axis=0) - lb_soft[0:1], 0.0, 1.0 - 1e-6)
    for l in range(DEPTH):
        h = _rmsnorm(x, attn_norm_w[l])
        x = x + _token_mixer(h, w_in[l], gate_bias[l], pool_w[l], pool_scale[l], pool_up[l],
                             lower_bounds[l], hgrn_norm_w[l], hgrn_up[l], w_out[l])
        h = _rmsnorm(x, ffn_norm_w[l])
        if l % 2 == 0:
            j = l // 2
            x = x + _swiglu(h, dense_w_gate[j], dense_w_up[j], dense_w_down[j])
        else:
            j = l // 2
            x = x + _moe(h, moe_router[j], moe_w_gate[j], moe_w_up[j], moe_w_down[j])
    return _rmsnorm(x, final_norm_w)
```

```cpp
#include <hip/hip_runtime.h>
#include <cstdio>
#include <cstdint>

#ifndef N_LAUNCHES
#define N_LAUNCHES 1
#endif

#define GAS __attribute__((address_space(1)))
#define LAS __attribute__((address_space(3)))
typedef unsigned short bf16_t;
typedef short bf16x8 __attribute__((ext_vector_type(8)));
typedef float f32x4 __attribute__((ext_vector_type(4)));
typedef float f32x2 __attribute__((ext_vector_type(2)));
typedef unsigned u32x4 __attribute__((ext_vector_type(4)));
typedef unsigned u32x2 __attribute__((ext_vector_type(2)));
typedef int i32x4 __attribute__((ext_vector_type(4)));
typedef int i32x8 __attribute__((ext_vector_type(8)));

constexpr int BATCH = 2, SEQ = 16384, D = 1024, M = BATCH * SEQ;
constexpr int PW = 512, HW = 512, INC = 4608, NGATE = 2048;
constexpr int DFF0 = 2816, DFF1 = 3584, NEXP = 8;
constexpr float EPS = 1e-6f;
constexpr int MAXTILES = 320;
constexpr int MAXSLOTS = MAXTILES * 256;

typedef __bf16 bf16x2_t __attribute__((ext_vector_type(2)));
__device__ __forceinline__ unsigned cvt_pk_bf16(float lo, float hi) { const bf16x2_t v = __builtin_convertvector((f32x2){lo, hi}, bf16x2_t); return __builtin_bit_cast(unsigned, v); }
__device__ __forceinline__ float f8_limit() { float l = 448.0f; asm volatile("" : "+s"(l)); return l; }
__device__ __forceinline__ float clamp_f8(float x, float lim) { return __builtin_amdgcn_fmed3f(x, -lim, lim); }
__device__ __forceinline__ unsigned pk4_fp8(float a, float b, float c, float d, float lim) {
    unsigned w = 0u; w = __builtin_amdgcn_cvt_pk_fp8_f32(clamp_f8(a, lim), clamp_f8(b, lim), w, false); w = __builtin_amdgcn_cvt_pk_fp8_f32(clamp_f8(c, lim), clamp_f8(d, lim), w, true); return w; }
__device__ __forceinline__ float bf_lo(unsigned w) { return __uint_as_float(w << 16); }
__device__ __forceinline__ float bf_hi(unsigned w) { return __uint_as_float(w & 0xffff0000u); }
__device__ __forceinline__ float bf2f(bf16_t b) { return __uint_as_float(((unsigned)b) << 16); }
__device__ __forceinline__ float fast_rcp(float x) { return __builtin_amdgcn_rcpf(x); }
__device__ __forceinline__ float fast_exp(float x) { return __builtin_amdgcn_exp2f(x * 1.44269504088896f); }
__device__ __forceinline__ float sigmoidf_(float x) { return fast_rcp(1.0f + fast_exp(-x)); }
__device__ __forceinline__ float siluf_(float x) { return x * sigmoidf_(x); }
__device__ __forceinline__ f32x2 sigmoid2(f32x2 x) { const f32x2 t = x * (f32x2){-1.44269504088896f, -1.44269504088896f}; f32x2 e; e.x = __builtin_amdgcn_exp2f(t.x); e.y = __builtin_amdgcn_exp2f(t.y);
    const f32x2 d = e + (f32x2){1.0f, 1.0f}; f32x2 r; r.x = __builtin_amdgcn_rcpf(d.x); r.y = __builtin_amdgcn_rcpf(d.y); return r; }
__device__ __forceinline__ f32x4 sigmoid4(f32x4 x) { const f32x2 a = sigmoid2((f32x2){x[0], x[1]}), b = sigmoid2((f32x2){x[2], x[3]}); return (f32x4){a.x, a.y, b.x, b.y}; }
__device__ __forceinline__ f32x4 silu4(f32x4 x) { return x * sigmoid4(x); }

namespace pg8 {
constexpr int BM = 256, BK = 64, HALF = 128, HTB = HALF * BK * 2, STAGE_BYTES = 8 * HTB, NXCD = 8, WGM = 8;
__host__ __device__ __forceinline__ int lds_byte(int r, int c) { const int st = (r >> 4) * 2 + (c >> 5), rr = r & 15, cc = c & 31, ob = rr * 64 + cc * 2; return st * 1024 + (ob ^ (((ob >> 9) & 1) << 5)); }
__host__ __device__ __forceinline__ void stage_rc(int b, int& R, int& C) { const int st = b / 1024, sb = b % 1024, swz = sb ^ (((sb >> 9) & 1) << 5); R = (st >> 1) * 16 + swz / 64; C = (st & 1) * 32 + (swz % 64) / 2; }
__host__ __device__ __forceinline__ int perm32(int rho) { const int n = rho >> 4, i = rho & 15; return 8 * (i >> 2) + 4 * n + (i & 3); }

struct Unit { unsigned A, B; int pm, pn, x; };
struct Gemm { const char* base; int lda, ldb, K; };

__device__ __forceinline__ bool grid_tile(int L, int nM, int nN, int& pm, int& pn) {
    const int nwg = nM * nN; if (L >= nwg) return false;
    int wgid = L; { const int q = nwg / NXCD, r = nwg % NXCD, xcd = wgid % NXCD, off = wgid / NXCD; wgid = (xcd < r ? xcd * (q + 1) : r * (q + 1) + (xcd - r) * q) + off; }
    const int nig = WGM * nN, gid = wgid / nig, fm = gid * WGM, gsz = (nM - fm) < WGM ? (nM - fm) : WGM;
    pm = fm + ((wgid % nig) % gsz); pn = (wgid % nig) / gsz; return true;
}

template <bool FP8, class Epi, class Sched>
__device__ __forceinline__ void gemm_phase(LAS unsigned char* lds, const Gemm g, const Sched& S, const Epi& E, int tid_in) {
    int tid_ = tid_in; asm volatile("" : "+v"(tid_));
    const int tid = tid_, wid = __builtin_amdgcn_readfirstlane(tid >> 6), lane = tid & 63, wr = wid >> 2, wc = wid & 3, fr = lane & 15, fq = lane >> 4;
    const int K = g.K, nt = K / BK;
    unsigned voffA, voffB;
    { int R, C; stage_rc(tid * 16, R, C); const int Rb = (R & ~31) + perm32(R & 31); voffA = (unsigned)(R * g.lda + C) * 2u; voffB = (unsigned)(Rb * g.ldb + C) * 2u; }
    const unsigned piecevoffA = 64u * (unsigned)g.lda * 2u, piecevoffB = 64u * (unsigned)g.ldb * 2u;
    const unsigned kstep = (unsigned)(BK * 2);
    const unsigned hstepA = (unsigned)HALF * g.lda * 2u, hstepB = (unsigned)HALF * g.ldb * 2u;
    const char* const gb = g.base;
    const unsigned ldsw = (unsigned)wid * 1024u;
    const int aoff = lds_byte(wr * 64 + fr, fq * 8), boff = lds_byte(wc * 32 + fr, fq * 8);
#define PG8_SA(b, h) (((b) * 2 + (h)) * HTB)
#define PG8_SB(b, h) ((4 + (b) * 2 + (h)) * HTB)
#define PG8_STAGE2(bufoff, gbase, voff, piece) do { _Pragma("unroll") for (int _i = 0; _i < 2; ++_i) \
        __builtin_amdgcn_global_load_lds((const unsigned*)((gb + (size_t)(unsigned)((gbase) + _i * (piece))) + (size_t)(voff)), (LAS unsigned*)(lds + (bufoff) + ldsw + _i * 8192), 16, 0, 0); } while (0)
#define PG8_STAGE(bufoff, gbase, voff) PG8_STAGE2(bufoff, gbase, voff, piece##voff)
#define PG8_LDA(dst, b, h) do { _Pragma("unroll") for (int m = 0; m < 4; ++m) _Pragma("unroll") for (int k = 0; k < 2; ++k) dst[m][k] = *(const LAS bf16x8*)(lds + PG8_SA(b, h) + aoff + m * 2048 + k * 1024); } while (0)
#define PG8_LDB(dst, b, h) do { _Pragma("unroll") for (int n = 0; n < 2; ++n) _Pragma("unroll") for (int k = 0; k < 2; ++k) dst[n][k] = *(const LAS bf16x8*)(lds + PG8_SB(b, h) + boff + n * 2048 + k * 1024); } while (0)
#define PG8_CAT(lo, hi) __builtin_shufflevector(__builtin_bit_cast(i32x4, lo), __builtin_bit_cast(i32x4, hi), 0, 1, 2, 3, 4, 5, 6, 7)
#define PG8_MMA(ai, bj, At, Bt) do { __builtin_amdgcn_s_setprio(1); _Pragma("unroll") for (int m = 0; m < 4; ++m) _Pragma("unroll") for (int n = 0; n < 2; ++n) { \
        if constexpr (FP8) acc[ai][bj][m][n] = __builtin_amdgcn_mfma_scale_f32_16x16x128_f8f6f4(PG8_CAT(Bt[n][0], Bt[n][1]), PG8_CAT(At[m][0], At[m][1]), acc[ai][bj][m][n], 0, 0, 0, 0, 0, 0);     \
        else { _Pragma("unroll") for (int k = 0; k < 2; ++k) acc[ai][bj][m][n] = __builtin_amdgcn_mfma_f32_16x16x32_bf16(Bt[n][k], At[m][k], acc[ai][bj][m][n], 0, 0, 0); } } \
        __builtin_amdgcn_s_setprio(0); } while (0)
#define PG8_WAIT_V(n) asm volatile("s_waitcnt vmcnt(" #n ")" ::: "memory")
#define PG8_WAIT_L(n) asm volatile("s_waitcnt lgkmcnt(" #n ")" ::: "memory")
#define PG8_BAR __builtin_amdgcn_s_barrier()
#define PG8_SCHED __builtin_amdgcn_sched_barrier(0)
    Unit cur, nxt; int ui = 0;
    if (!S.next(0, cur)) return;
    f32x4 acc[2][2][4][2];
#pragma unroll
    for (int a = 0; a < 2; ++a)
#pragma unroll
        for (int b = 0; b < 2; ++b)
#pragma unroll
            for (int m = 0; m < 4; ++m)
#pragma unroll
                for (int n = 0; n < 2; ++n) acc[a][b][m][n] = (f32x4){0.f, 0.f, 0.f, 0.f};
    bf16x8 At[4][2], B0[2][2], B1[2][2];
    unsigned cA = cur.A, cB = cur.B;
    PG8_STAGE(PG8_SB(0, 0), cB, voffB); PG8_STAGE(PG8_SB(0, 1), cB + hstepB, voffB); PG8_STAGE(PG8_SA(0, 0), cA, voffA); PG8_STAGE(PG8_SA(0, 1), cA + hstepA, voffA);
    if (wr == 1) PG8_BAR;
    PG8_WAIT_V(2); PG8_BAR;
    PG8_STAGE(PG8_SB(1, 0), cB + kstep, voffB); PG8_STAGE(PG8_SA(1, 0), cA + kstep, voffA); PG8_STAGE(PG8_SB(1, 1), cB + hstepB + kstep, voffB);
    PG8_WAIT_V(6); PG8_BAR;
    for (;;) {
        const bool has_next = S.next(ui + 1, nxt);
        const unsigned nA = has_next ? nxt.A : cA, nB = has_next ? nxt.B : cB;
#pragma unroll 1
        for (int t = 0; t < nt; t += 2) {
            const bool last = (t == nt - 2);
            const unsigned a1 = cA + (unsigned)(t + 1) * kstep;
            const unsigned a2 = last ? nA : cA + (unsigned)(t + 2) * kstep, b2 = last ? nB : cB + (unsigned)(t + 2) * kstep;
            const unsigned a3 = a2 + kstep, b3 = b2 + kstep;
            const bool relax = (t == 0) && (ui > 0);
#define PG8_WAIT_FIRST() do { if (relax) { if constexpr (Epi::NST == 8) PG8_WAIT_V(16); else PG8_WAIT_V(24); } else PG8_WAIT_V(8); } while (0)
            PG8_LDB(B0, 0, 0); PG8_LDB(B1, 0, 1); PG8_SCHED; PG8_LDA(At, 0, 0); PG8_STAGE(PG8_SA(1, 1), a1 + hstepA, voffA);
            PG8_WAIT_FIRST(); PG8_WAIT_L(0); PG8_BAR; PG8_MMA(0, 0, At, B0); PG8_MMA(0, 1, At, B1); PG8_BAR; PG8_SCHED;
            PG8_LDA(At, 0, 1); PG8_STAGE(PG8_SB(0, 0), b2, voffB); PG8_STAGE(PG8_SB(0, 1), b2 + hstepB, voffB); PG8_STAGE(PG8_SA(0, 0), a2, voffA);
            PG8_WAIT_FIRST(); PG8_WAIT_L(0); PG8_BAR; PG8_MMA(1, 0, At, B0); PG8_MMA(1, 1, At, B1); PG8_BAR; PG8_SCHED;
            PG8_LDB(B0, 1, 0); PG8_LDB(B1, 1, 1); PG8_SCHED; PG8_LDA(At, 1, 0); PG8_STAGE(PG8_SA(0, 1), a2 + hstepA, voffA);
            PG8_WAIT_V(8); PG8_WAIT_L(0); PG8_BAR; PG8_MMA(0, 0, At, B0); PG8_MMA(0, 1, At, B1); PG8_BAR; PG8_SCHED;
            PG8_LDA(At, 1, 1); PG8_STAGE(PG8_SB(1, 0), b3, voffB); PG8_STAGE(PG8_SB(1, 1), b3 + hstepB, voffB); PG8_STAGE(PG8_SA(1, 0), a3, voffA);
            PG8_WAIT_V(8); PG8_WAIT_L(0); PG8_BAR; PG8_MMA(1, 0, At, B0); PG8_MMA(1, 1, At, B1); PG8_BAR; PG8_SCHED;
        }
        if (wr == 0) PG8_BAR;
        E(acc, cur, wr, wc, fr, fq);
        if (!has_next) break;
#pragma unroll
        for (int a = 0; a < 2; ++a)
#pragma unroll
            for (int b = 0; b < 2; ++b)
#pragma unroll
                for (int m = 0; m < 4; ++m)
#pragma unroll
                    for (int n = 0; n < 2; ++n) acc[a][b][m][n] = (f32x4){0.f, 0.f, 0.f, 0.f};
        cur = nxt; cA = nA; cB = nB; ++ui;
        if (wr == 1) PG8_BAR;
    }
    PG8_WAIT_V(0);
    PG8_BAR;
#undef PG8_SA
#undef PG8_SB
#undef PG8_STAGE
#undef PG8_STAGE2
#undef PG8_LDA
#undef PG8_LDB
#undef PG8_MMA
#undef PG8_WAIT_FIRST
#undef PG8_CAT
#undef PG8_WAIT_V
#undef PG8_WAIT_L
#undef PG8_BAR
#undef PG8_SCHED
}
}

constexpr size_t EPI_MiB = 1u << 20;
constexpr size_t EPI_WS_U = 111 * EPI_MiB, EPI_WS_Q = 143 * EPI_MiB, EPI_WS_LF = 175 * EPI_MiB, EPI_WS_V = 239 * EPI_MiB, EPI_WS_GG = 271 * EPI_MiB, EPI_WS_GT = 303 * EPI_MiB, EPI_WS_H = 47 * EPI_MiB, EPI_WS_LB = 1 * EPI_MiB;
typedef f32x4 AccT[2][2][4][2];
#define EPI_ROW0(u) ((u).pm * 256 + wr * 64 + fr)
__device__ __forceinline__ u32x4 pack8(const f32x4 a, const f32x4 b) { u32x4 w; w.x = cvt_pk_bf16(a[0], a[1]); w.y = cvt_pk_bf16(a[2], a[3]); w.z = cvt_pk_bf16(b[0], b[1]); w.w = cvt_pk_bf16(b[2], b[3]); return w; }

struct EpiIn {
    static constexpr int NST = 16;
    unsigned char* ws; const float* gbias; int layer;
    __device__ __forceinline__ void operator()(const AccT& acc, const pg8::Unit& u, int wr, int wc, int fr, int fq) const {
        unsigned char* wb = ws; asm volatile("" : "+s"(wb));
        GAS unsigned char* const wg = (GAS unsigned char*)wb;
        GAS bf16_t* const U = (GAS bf16_t*)(wg + EPI_WS_U); GAS bf16_t* const Q = (GAS bf16_t*)(wg + EPI_WS_Q); GAS bf16_t* const V = (GAS bf16_t*)(wg + EPI_WS_V); GAS bf16_t* const G = (GAS bf16_t*)(wg + EPI_WS_GG); GAS bf16_t* const GT = (GAS bf16_t*)(wg + EPI_WS_GT);
        GAS float* const LF = (GAS float*)(wg + EPI_WS_LF); const GAS float* const lb = (const GAS float*)(wg + EPI_WS_LB) + layer * HW;
        const int row0 = EPI_ROW0(u), cw = wc * 32 + 8 * fq;
        if (u.pn >= 10) {
            const int c0 = (u.pn - 10) * 256 + cw;
            f32x4 bb[2][2];
#pragma unroll
            for (int bj = 0; bj < 2; ++bj) { bb[bj][0] = *(const f32x4*)(gbias + c0 + bj * 128); bb[bj][1] = *(const f32x4*)(gbias + c0 + bj * 128 + 4); }
#pragma unroll
            for (int bj = 0; bj < 2; ++bj) { const int c = c0 + bj * 128; const f32x4 b0 = bb[bj][0], b1 = bb[bj][1];
#pragma unroll
                for (int ai = 0; ai < 2; ++ai)
#pragma unroll
                    for (int m = 0; m < 4; ++m) { f32x4 v0 = acc[ai][bj][m][0] + b0, v1 = acc[ai][bj][m][1] + b1;
#pragma unroll
                        for (int j = 0; j < 4; ++j) { v0[j] = sigmoidf_(v0[j]); v1[j] = sigmoidf_(v1[j]); }
                        *(GAS u32x4*)(GT + (size_t)(row0 + ai * 128 + m * 16) * NGATE + c) = pack8(v0, v1); } }
        } else if ((u.pn >> 1) == 2) {
            const int c0 = (u.pn - 4) * 256 + cw;
            f32x4 ll[2][2];
#pragma unroll
            for (int bj = 0; bj < 2; ++bj) { ll[bj][0] = *(const GAS f32x4*)(lb + c0 + bj * 128); ll[bj][1] = *(const GAS f32x4*)(lb + c0 + bj * 128 + 4); }
#pragma unroll
            for (int bj = 0; bj < 2; ++bj) { const int c = c0 + bj * 128; const f32x4 l0 = ll[bj][0], l1 = ll[bj][1];
#pragma unroll
                for (int ai = 0; ai < 2; ++ai)
#pragma unroll
                    for (int m = 0; m < 4; ++m) { f32x4 v0 = acc[ai][bj][m][0], v1 = acc[ai][bj][m][1];
                        { const f32x4 s0 = sigmoid4(v0), s1 = sigmoid4(v1); const f32x4 f0 = __builtin_elementwise_max(l0, (f32x4){1e-30f, 1e-30f, 1e-30f, 1e-30f}) + ((f32x4){1.f, 1.f, 1.f, 1.f} - l0) * s0, f1 = __builtin_elementwise_max(l1, (f32x4){1e-30f, 1e-30f, 1e-30f, 1e-30f}) + ((f32x4){1.f, 1.f, 1.f, 1.f} - l1) * s1;
#pragma unroll
                          for (int j = 0; j < 4; ++j) { v0[j] = __logf(f0[j]); v1[j] = __logf(f1[j]); } }
                        GAS float* o = LF + (size_t)(row0 + ai * 128 + m * 16) * HW + c; *(GAS f32x4*)o = v0; *(GAS f32x4*)(o + 4) = v1; } }
        } else {
            const int kind = u.pn >> 1; GAS bf16_t* dst = kind == 0 ? U : (kind == 1 ? Q : (kind == 3 ? V : G)); const bool act = (kind == 1) || (kind == 4);
            const int c0 = (u.pn & 1) * 256 + cw;
#pragma unroll
            for (int bj = 0; bj < 2; ++bj) { const int c = c0 + bj * 128;
#pragma unroll
                for (int ai = 0; ai < 2; ++ai)
#pragma unroll
                    for (int m = 0; m < 4; ++m) { f32x4 v0 = acc[ai][bj][m][0], v1 = acc[ai][bj][m][1];
                        if (act) { v0 = silu4(v0); v1 = silu4(v1); }
                        *(GAS u32x4*)(dst + (size_t)(row0 + ai * 128 + m * 16) * PW + c) = pack8(v0, v1); } }
        }
    }
};
struct EpiGate8 {
    static constexpr int NST = 16;
    unsigned char* ws; const float* gbias; float cs;
    __device__ __forceinline__ void operator()(const AccT& acc, const pg8::Unit& u, int wr, int wc, int fr, int fq) const {
        unsigned char* wb = ws; float csl = cs; asm volatile("" : "+s"(wb), "+s"(csl));
        GAS bf16_t* const GT = (GAS bf16_t*)((GAS unsigned char*)wb + EPI_WS_GT);
        const int row0 = EPI_ROW0(u), c0 = u.pn * 256 + wc * 32 + 8 * fq;
        f32x4 bb[2][2];
#pragma unroll
        for (int bj = 0; bj < 2; ++bj) { bb[bj][0] = *(const f32x4*)(gbias + c0 + bj * 128); bb[bj][1] = *(const f32x4*)(gbias + c0 + bj * 128 + 4); }
#pragma unroll
        for (int bj = 0; bj < 2; ++bj) { const int c = c0 + bj * 128;
#pragma unroll
            for (int ai = 0; ai < 2; ++ai)
#pragma unroll
                for (int m = 0; m < 4; ++m) { f32x4 v0 = acc[ai][bj][m][0] * csl + bb[bj][0], v1 = acc[ai][bj][m][1] * csl + bb[bj][1];
                    v0 = sigmoid4(v0); v1 = sigmoid4(v1);
                    *(GAS u32x4*)(GT + (size_t)(row0 + ai * 128 + m * 16) * NGATE + c) = pack8(v0, v1); } }
    }
};
struct EpiU {
    static constexpr int NST = 16;
    unsigned char* ws;
    __device__ __forceinline__ void operator()(const AccT& acc, const pg8::Unit& u, int wr, int wc, int fr, int fq) const {
        unsigned char* wb = ws; asm volatile("" : "+s"(wb));
        GAS unsigned char* const wg = (GAS unsigned char*)wb;
        GAS bf16_t* const MG = (GAS bf16_t*)(wg + EPI_WS_H); const GAS bf16_t* const GT = (const GAS bf16_t*)(wg + EPI_WS_GT);
        const int row0 = EPI_ROW0(u), c0 = u.pn * 256 + wc * 32 + 8 * fq;
#pragma unroll
        for (int ai = 0; ai < 2; ++ai) {
            u32x4 gw[4][2], tw[4][2];
#pragma unroll
            for (int m = 0; m < 4; ++m)
#pragma unroll
                for (int bj = 0; bj < 2; ++bj) { const size_t row = (size_t)(row0 + ai * 128 + m * 16); const int c = c0 + bj * 128;
                    gw[m][bj] = *(const GAS u32x4*)(GT + row * NGATE + u.x * 1024 + c);
                    tw[m][bj] = u.x ? *(const GAS u32x4*)(MG + row * D + c) : (u32x4){0u, 0u, 0u, 0u}; }
#pragma unroll
            for (int m = 0; m < 4; ++m)
#pragma unroll
                for (int bj = 0; bj < 2; ++bj) { const size_t row = (size_t)(row0 + ai * 128 + m * 16); const int c = c0 + bj * 128; const u32x4 g = gw[m][bj], t = tw[m][bj];
                    f32x4 v0 = acc[ai][bj][m][0], v1 = acc[ai][bj][m][1];
                    v0[0] = v0[0] * bf_lo(g.x) + bf_lo(t.x); v0[1] = v0[1] * bf_hi(g.x) + bf_hi(t.x); v0[2] = v0[2] * bf_lo(g.y) + bf_lo(t.y); v0[3] = v0[3] * bf_hi(g.y) + bf_hi(t.y);
                    v1[0] = v1[0] * bf_lo(g.z) + bf_lo(t.z); v1[1] = v1[1] * bf_hi(g.z) + bf_hi(t.z); v1[2] = v1[2] * bf_lo(g.w) + bf_lo(t.w); v1[3] = v1[3] * bf_hi(g.w) + bf_hi(t.w);
                    *(GAS u32x4*)(MG + row * D + c) = pack8(v0, v1); }
        }
    }
};
struct EpiRow {
    static constexpr int NST = 16;
    bf16_t* O; int ldo; const float* rowscale; float cs;
    __device__ __forceinline__ void operator()(const AccT& acc, const pg8::Unit& u, int wr, int wc, int fr, int fq) const {
        const int row0 = EPI_ROW0(u), c0 = u.pn * 256 + wc * 32 + 8 * fq; float csl = cs; asm volatile("" : "+s"(csl));
        float sc[2][4];
#pragma unroll
        for (int ai = 0; ai < 2; ++ai)
#pragma unroll
            for (int m = 0; m < 4; ++m) sc[ai][m] = rowscale ? rowscale[row0 + ai * 128 + m * 16] * csl : csl;
#pragma unroll
        for (int ai = 0; ai < 2; ++ai)
#pragma unroll
            for (int m = 0; m < 4; ++m) { const size_t row = (size_t)(row0 + ai * 128 + m * 16); const float s = sc[ai][m];
#pragma unroll
                for (int bj = 0; bj < 2; ++bj) *(u32x4*)(O + row * ldo + c0 + bj * 128) = pack8(acc[ai][bj][m][0] * s, acc[ai][bj][m][1] * s); }
    }
};
struct EpiSwi {
    static constexpr int NST = 8;
    bf16_t* ACT; int ldact;
    __device__ __forceinline__ void operator()(const AccT& acc, const pg8::Unit& u, int wr, int wc, int fr, int fq) const {
        const int row0 = u.x * 256 + wr * 64 + fr, c0 = u.pn * 128 + wc * 32 + 8 * fq;
#pragma unroll
        for (int ai = 0; ai < 2; ++ai)
#pragma unroll
            for (int m = 0; m < 4; ++m) { f32x4 v0 = acc[ai][0][m][0], v1 = acc[ai][0][m][1]; const f32x4 u0 = acc[ai][1][m][0], u1 = acc[ai][1][m][1];
                v0 = silu4(v0) * u0; v1 = silu4(v1) * u1;
                *(u32x4*)(ACT + (size_t)(row0 + ai * 128 + m * 16) * ldact + c0) = pack8(v0, v1); }
    }
};

struct EpiSwi8 {
    static constexpr int NST = 8;
    unsigned char* ACT; int ldact; float in_scale, out_scale;
    __device__ __forceinline__ void operator()(const AccT& acc, const pg8::Unit& u, int wr, int wc, int fr, int fq) const {
        const int row0 = u.x * 256 + wr * 64 + fr, c0 = u.pn * 128 + wc * 32 + 8 * fq; const float lim = f8_limit();
        float kE_ = -in_scale * 1.44269504088896f, kU_ = in_scale * in_scale * out_scale; asm volatile("" : "+s"(kE_), "+s"(kU_));
        const f32x2 kE = {kE_, kE_}, kU = {kU_, kU_}, one = {1.0f, 1.0f};
#pragma unroll
        for (int ai = 0; ai < 2; ++ai)
#pragma unroll
            for (int m = 0; m < 4; ++m) { unsigned w[2];
#pragma unroll
                for (int n = 0; n < 2; ++n) { const f32x4 g4 = acc[ai][0][m][n], u4 = acc[ai][1][m][n]; f32x2 o[2];
#pragma unroll
                    for (int h = 0; h < 2; ++h) { const f32x2 g = {g4[2 * h], g4[2 * h + 1]}, uu = {u4[2 * h], u4[2 * h + 1]};
                        const f32x2 t = g * kE; f32x2 e; e.x = __builtin_amdgcn_exp2f(t.x); e.y = __builtin_amdgcn_exp2f(t.y);
                        const f32x2 d = e + one; f32x2 r; r.x = __builtin_amdgcn_rcpf(d.x); r.y = __builtin_amdgcn_rcpf(d.y);
                        o[h] = (g * r) * (uu * kU); }
                    w[n] = pk4_fp8(o[0].x, o[0].y, o[1].x, o[1].y, lim); }
                u32x2 ww; ww.x = w[0]; ww.y = w[1];
                *(u32x2*)(ACT + (size_t)(row0 + ai * 128 + m * 16) * ldact + c0) = ww;
                __builtin_amdgcn_sched_barrier(0); }
    }
};

struct GridOrder {
    unsigned Abase, Bbase, atile, btile; int nM, nN, G, c;
    __device__ __forceinline__ bool next(int i, pg8::Unit& u) const {
        int pm, pn; if (!pg8::grid_tile(i * G + c, nM, nN, pm, pn)) return false;
        u.pm = pm; u.pn = pn; u.x = 0; u.A = Abase + (unsigned)pm * atile; u.B = Bbase + (unsigned)pn * btile; return true; }
};
struct UOrder {
    unsigned Abase, Bbase; int G, c;
    __device__ __forceinline__ bool next(int i, pg8::Unit& u) const {
        int pm, pn; if (!pg8::grid_tile((i >> 1) * G + c, M / 256, D / 256, pm, pn)) return false;
        u.pm = pm; u.pn = pn; u.x = i & 1; u.A = Abase + (unsigned)pm * (256u * 1024 * 2) + (unsigned)(i & 1) * 1024u; u.B = Bbase + (unsigned)pn * (256u * 1024 * 2) + (unsigned)(i & 1) * 1024u; return true; }
};
struct GuOrder {
    unsigned Abase, Bbase; const int* tile_expert; unsigned bexp, tileb; int t0, nT, nN, G, c;
    __device__ __forceinline__ bool next(int i, pg8::Unit& u) const {
        int pm, pn; if (!pg8::grid_tile(i * G + c, nT, nN, pm, pn)) return false;
        const int tile = t0 + pm; const int e = tile_expert ? __builtin_amdgcn_readfirstlane(__hip_atomic_load(tile_expert + tile, __ATOMIC_RELAXED, __HIP_MEMORY_SCOPE_AGENT)) : 0;
        u.pm = tile; u.pn = pn; u.x = pm; u.A = Abase + (unsigned)tile * tileb; u.B = Bbase + (unsigned)e * bexp + (unsigned)pn * tileb; return true; }
};
struct DownOrder {
    unsigned Abase, Bbase; const int* tile_expert; unsigned bexp, atile; int t0, nT, G, c;
    __device__ __forceinline__ bool next(int i, pg8::Unit& u) const {
        int pm, pn; if (!pg8::grid_tile(i * G + c, nT, D / 256, pm, pn)) return false;
        const int tile = t0 + pm; const int e = tile_expert ? __builtin_amdgcn_readfirstlane(__hip_atomic_load(tile_expert + tile, __ATOMIC_RELAXED, __HIP_MEMORY_SCOPE_AGENT)) : 0;
        u.pm = tile; u.pn = pn; u.x = pm; u.A = Abase + (unsigned)pm * atile; u.B = Bbase + (unsigned)e * bexp + (unsigned)pn * atile; return true; }
};

constexpr size_t MiB = 1u << 20;
constexpr size_t WS_CTL = 0, CTL_BYTES = 1 * MiB;
constexpr size_t WS_SMALL = 1 * MiB;
constexpr size_t SM_LB = 0, SM_CNTWG = 4096, SM_TOKE = 16384, SM_TOKW = 147456, SM_TOKS = 409600, SM_ROWIDX = 671744, SM_ROWSC = 999424, SM_TILEEXP = 1327104, SM_NT = 1328384, SM_DT = 1536 * 1024;
constexpr int MAXT = 272, NSLOT = MAXT * 256;
static_assert(SM_ROWIDX + (size_t)NSLOT * 4 <= SM_ROWSC && SM_ROWSC + (size_t)NSLOT * 4 <= SM_TILEEXP && SM_DT + 256 * 128 * 4 <= 3 * MiB, "small map");
constexpr size_t WS_WIN = 4 * MiB, WS_WU = 22 * MiB, WS_WOUT = 26 * MiB, WS_DGU = 30 * MiB, WS_DDN = 41 * MiB;
constexpr size_t WS_H = 47 * MiB;
constexpr size_t WS_U = 111 * MiB, WS_Q = 143 * MiB, WS_LF = 175 * MiB, WS_V = 239 * MiB, WS_GG = 271 * MiB, WS_GT = 303 * MiB, WS_A2 = 431 * MiB, WS_SL = 495 * MiB, WS_SI = 511 * MiB;
constexpr size_t WS_H8 = WS_SL;
constexpr size_t WS_WG8 = 528 * MiB;
constexpr size_t WS_MO = 111 * MiB;
constexpr size_t WS_ACT0 = 111 * MiB, WS_DN0 = 287 * MiB;
constexpr size_t WS_ACT1 = 111 * MiB, WS_H2G = 237 * MiB, WS_DN1 = 305 * MiB, WS_MW = 441 * MiB;
constexpr int MOE_G0 = 128, MOE_G1 = 144, MOE_NG = 2;
constexpr size_t MW_GU_E = (size_t)2 * DFF1 * D, MW_DN_E = (size_t)D * DFF1;
constexpr size_t WS_MWD = WS_MW + NEXP * MW_GU_E;
constexpr size_t WS_END = 548 * MiB;
constexpr float F8_W = 256.0f, F8_H = 16.0f, F8_A = 8.0f;
static_assert(WS_MWD + NEXP * MW_DN_E <= WS_END && WS_H2G + (size_t)NSLOT * D <= WS_DN1 && WS_DN1 + (size_t)NSLOT * D * 2 <= WS_MW && WS_ACT1 + (size_t)MOE_G1 * 256 * DFF1 <= WS_H2G && MOE_G0 + MOE_G1 >= MAXT && WS_SI + 16 * MiB <= WS_END, "ws map");
static_assert(EPI_WS_U == WS_U && EPI_WS_Q == WS_Q && EPI_WS_LF == WS_LF && EPI_WS_V == WS_V && EPI_WS_GG == WS_GG && EPI_WS_GT == WS_GT && EPI_WS_H == WS_H && EPI_WS_LB == WS_SMALL + SM_LB, "epilogue offsets");
static_assert(WS_ACT0 + (size_t)M * DFF0 * 2 <= WS_DN0 && WS_DDN + (size_t)D * DFF0 * 2 <= WS_H, "ws map 2");
constexpr int CW_BAR = 4096;

constexpr int RING_BYTES = 131072, MISC_OFF = RING_BYTES, LDS_BYTES = 147456;
constexpr int NW = 8, NT = 512;
#define LDS_WAIT() asm volatile("s_waitcnt lgkmcnt(0)" ::: "memory")
#define VM_WAIT() asm volatile("s_waitcnt vmcnt(0)" ::: "memory")

#define XB_TMO      128
#define XB_XCNT(j)  (256  + 64 * (j))
#define XB_XSUB(j)  (1280 + 64 * (j))
#define XB_XGEN(j)  (2304 + 64 * (j))
#define XB_TOP      3328
#define XB_TOPGEN   3392
#define XCD_BAR_WORDS 3456
#define XB_SPIN_CAP (1u << 18)
__device__ __forceinline__ unsigned xb_ld(unsigned* p)              { return __hip_atomic_load(p, __ATOMIC_RELAXED, __HIP_MEMORY_SCOPE_AGENT); }
__device__ __forceinline__ unsigned xb_add(unsigned* p, unsigned v) { return __hip_atomic_fetch_add(p, v, __ATOMIC_RELAXED, __HIP_MEMORY_SCOPE_AGENT); }
__device__ __forceinline__ unsigned xb_xcc_id() { return (unsigned)__builtin_amdgcn_s_getreg((3 << 11) | 20) & 0xFu; }
#define XB_SPIN(cond, bar) do { unsigned _sp = 0; while (cond) { __builtin_amdgcn_s_sleep(1); \
    if ((++_sp & 255u) == 0u) { if (xb_ld(&(bar)[XB_TMO])) break; if (_sp > XB_SPIN_CAP) { atomicAdd(&(bar)[XB_TMO], 1u); break; } } } } while (0)
struct XcdBarrier { unsigned* bar; unsigned x; volatile LAS unsigned* st; };
__device__ __forceinline__ XcdBarrier xcd_barrier_post(unsigned* bar, volatile LAS unsigned* st, int tid) {
    XcdBarrier b; b.bar = bar; b.x = xb_xcc_id(); b.st = st;
    if (tid == 0) (void)xb_add(&bar[XB_XCNT(b.x)], 1u);
    return b;
}
__device__ __forceinline__ void xcd_barrier_complete(unsigned* bar, unsigned x, unsigned& nloc, unsigned& nx) {
    const unsigned G = gridDim.x * gridDim.y * gridDim.z;
    unsigned sum, cnt, mine, sp = 0u;
    for (;;) {
        sum = 0u; cnt = 0u; mine = 0u;
#pragma unroll
        for (unsigned j = 0; j < 16; ++j) { const unsigned c = xb_ld(&bar[XB_XCNT(j)]); sum += c; cnt += (c > 0u) ? 1u : 0u; mine = (j == x) ? c : mine; }
        if (sum == G) break;
        __builtin_amdgcn_s_sleep(1);
        if ((++sp & 255u) == 0u) { if (xb_ld(&bar[XB_TMO])) break; if (sp > XB_SPIN_CAP) { atomicAdd(&bar[XB_TMO], 1u); break; } }
    }
    nloc = mine > 0u ? mine : 1u; nx = cnt > 0u ? cnt : 1u;
}
__device__ __forceinline__ void xcd_barrier(const XcdBarrier& b, int tid) {
    asm volatile("s_waitcnt vmcnt(0)" ::: "memory");
    __syncthreads();
    if (tid == 0) {
        unsigned* bar = b.bar;
        __builtin_amdgcn_s_waitcnt(0);
        unsigned nloc = b.st[0], nx = b.st[1];
        if (nloc == 0u) { xcd_barrier_complete(bar, b.x, nloc, nx); b.st[0] = nloc; b.st[1] = nx; }
        const unsigned old = xb_add(&bar[XB_XSUB(b.x)], 1u);
        const unsigned gen = old / nloc;
        if (old + 1u == (gen + 1u) * nloc) {
            __builtin_amdgcn_fence(__ATOMIC_RELEASE, "agent");
            asm volatile("s_waitcnt vmcnt(0)" ::: "memory");
            const unsigned og = xb_add(&bar[XB_TOP], 1u);
            const unsigned tg = og / nx;
            if (og + 1u == (tg + 1u) * nx) xb_add(&bar[XB_TOPGEN], 1u);
            else XB_SPIN(xb_ld(&bar[XB_TOPGEN]) == tg, bar);
            __builtin_amdgcn_fence(__ATOMIC_ACQUIRE, "agent");
            xb_add(&bar[XB_XGEN(b.x)], 1u);
            asm volatile("s_waitcnt vmcnt(0)" ::: "memory");
        } else {
            XB_SPIN(xb_ld(&bar[XB_XGEN(b.x)]) == gen, bar);
            __builtin_amdgcn_fence(__ATOMIC_ACQUIRE, "agent");
            asm volatile("s_waitcnt vmcnt(0)" ::: "memory");
        }
    }
    __syncthreads();
}

__device__ __forceinline__ float shfl_xor_l(float v, int o, int lane) { return __builtin_bit_cast(float, __builtin_amdgcn_ds_bpermute((lane ^ o) << 2, __builtin_bit_cast(int, v))); }
__device__ __forceinline__ float wave_sum(float v, int lane) {
#pragma unroll
    for (int o = 1; o < 64; o <<= 1) v += shfl_xor_l(v, o, lane);
    return v;
}
__device__ __forceinline__ void tr_item(const float* W, int N, int k0, int n0, bf16_t* dst, int ldd, LAS float* scr, int lane) {
    float v[32];
#pragma unroll
    for (int i = 0; i < 32; ++i) v[i] = W[(size_t)(k0 + 2 * i + (lane >> 5)) * N + n0 + (lane & 31)];
#pragma unroll
    for (int i = 0; i < 32; ++i) scr[(2 * i + (lane >> 5)) * 33 + (lane & 31)] = v[i];
    LDS_WAIT();
    const int c = lane & 7;
#pragma unroll
    for (int j = 0; j < 4; ++j) { const int n = (lane >> 3) + 8 * j; const LAS float* s = scr + (8 * c) * 33 + n;
        u32x4 o; o.x = cvt_pk_bf16(s[0 * 33], s[1 * 33]); o.y = cvt_pk_bf16(s[2 * 33], s[3 * 33]); o.z = cvt_pk_bf16(s[4 * 33], s[5 * 33]); o.w = cvt_pk_bf16(s[6 * 33], s[7 * 33]);
        *(u32x4*)(dst + (size_t)n * ldd + 8 * c) = o; }
    LDS_WAIT();
}
__device__ __forceinline__ void tr_item8(const float* W, int N, int k0, int n0, unsigned char* dst, int ldd, float scale, LAS float* scr, int lane) {
    float v[32];
#pragma unroll
    for (int i = 0; i < 32; ++i) v[i] = W[(size_t)(k0 + 2 * i + (lane >> 5)) * N + n0 + (lane & 31)];
#pragma unroll
    for (int i = 0; i < 32; ++i) scr[(2 * i + (lane >> 5)) * 33 + (lane & 31)] = v[i] * scale;
    LDS_WAIT();
    const int c = lane & 7; const float lim = f8_limit();
#pragma unroll
    for (int j = 0; j < 4; ++j) { const int n = (lane >> 3) + 8 * j; const LAS float* s = scr + (8 * c) * 33 + n;
        u32x2 o; o.x = pk4_fp8(s[0 * 33], s[1 * 33], s[2 * 33], s[3 * 33], lim); o.y = pk4_fp8(s[4 * 33], s[5 * 33], s[6 * 33], s[7 * 33], lim);
        *(u32x2*)(dst + (size_t)n * ldd + 8 * c) = o; }
    LDS_WAIT();
}
__device__ __forceinline__ void tr_plain(const float* W, int K, int N, bf16_t* WT, int ldd, int kcol0, int it, LAS float* scr, int lane) {
    const int nblk = N / 32, kb = it / nblk, nb = it % nblk;
    tr_item(W, N, 64 * kb, 32 * nb, WT + (size_t)(32 * nb) * ldd + kcol0 + 64 * kb, ldd, scr, lane);
}
__device__ __forceinline__ void tr_gu(const float* W, int dff, int isup, bf16_t* WT, int it, LAS float* scr, int lane) {
    const int nblk = dff / 32, kb = it / nblk, nb = it % nblk, n0 = 32 * nb, drow = 256 * (n0 >> 7) + 128 * isup + (n0 & 127);
    tr_item(W, dff, 64 * kb, n0, WT + (size_t)drow * D + 64 * kb, D, scr, lane);
}

struct Args { const float* in[20]; float* out; unsigned char* ws; int lo, hi; };
#define CAS __attribute__((address_space(4)))
struct Ctx {
    LAS unsigned char* lds; int tid, lane, wave, G, bid;
    const CAS Args* a;
};
#define CIN(i) (C.a->in[i])
#define C_WS (C.a->ws)
#define C_OUT (C.a->out)
#define C_G (C.G)
#define C_BID (C.bid)
#define WSP(T, off) ((T*)(C_WS + (off)))
#define SMP(T, off) ((T*)(C_WS + WS_SMALL + (off)))

__device__ __forceinline__ void phase_prologue(Ctx& C) {
    LAS float* scr = (LAS float*)(C.lds + C.wave * 16384);
    const int gw = C_BID * NW + C.wave, NGW = C_G * NW;
    constexpr int I_IN = (D / 64) * ((INC - NGATE) / 32), I_HU = (HW / 64) * (D / 32), I_WO = (D / 64) * (D / 32), I_GU = (D / 64) * (DFF0 / 32), I_DN = (DFF0 / 64) * (D / 32);
    constexpr int I_G8 = (D / 64) * (NGATE / 32);
    constexpr int NITEMS = 2 * (I_IN + I_HU + I_WO) + 2 * I_GU + I_DN + 2 * I_G8;
    for (int it = gw; it < NITEMS; it += NGW) {
        int r = it;
        if (r < 2 * I_IN) { const int l = r / I_IN, q = r % I_IN, nblk = (INC - NGATE) / 32, kb = q / nblk, nb = q % nblk;
            tr_item(CIN(2) + (size_t)l * D * INC, INC, 64 * kb, 32 * nb, WSP(bf16_t, WS_WIN) + (size_t)l * INC * D + (size_t)(32 * nb) * D + 64 * kb, D, scr, C.lane); continue; } r -= 2 * I_IN;
        if (r < 2 * I_HU) { const int l = r / I_HU; tr_plain(CIN(9) + (size_t)l * HW * D, HW, D, WSP(bf16_t, WS_WU) + (size_t)l * D * D, D, 512, r % I_HU, scr, C.lane); continue; } r -= 2 * I_HU;
        if (r < 2 * I_WO) { const int l = r / I_WO; tr_plain(CIN(10) + (size_t)l * D * D, D, D, WSP(bf16_t, WS_WOUT) + (size_t)l * D * D, D, 0, r % I_WO, scr, C.lane); continue; } r -= 2 * I_WO;
        if (r < I_GU) { tr_gu(CIN(12), DFF0, 0, WSP(bf16_t, WS_DGU), r, scr, C.lane); continue; } r -= I_GU;
        if (r < I_GU) { tr_gu(CIN(13), DFF0, 1, WSP(bf16_t, WS_DGU), r, scr, C.lane); continue; } r -= I_GU;
        if (r < I_DN) { tr_plain(CIN(14), DFF0, D, WSP(bf16_t, WS_DDN), DFF0, 0, r, scr, C.lane); continue; } r -= I_DN;
        { const int l = r / I_G8, q = r % I_G8, nblk = NGATE / 32, kb = q / nblk, nb = q % nblk;
          tr_item8(CIN(2) + (size_t)l * D * INC, INC, 64 * kb, (INC - NGATE) + 32 * nb, C_WS + WS_WG8 + (size_t)l * NGATE * D + (size_t)(32 * nb) * D + 64 * kb, D, F8_W, scr, C.lane); }
    }
    for (int it = gw; it < 2 * 4 * 16 * 16; it += NGW) {
        const int nb = it & 15, kb = (it >> 4) & 15, g = (it >> 8) & 3, l = it >> 10;
        const float* pw = CIN(4) + ((size_t)l * PW + g * 128 + kb * 8) * 128; const float* ps = CIN(5) + l * PW + g * 128; const float* pu = CIN(6) + ((size_t)l * PW + g * 128) * D + nb * 64 + C.lane;
        float acc8[8];
#pragma unroll
        for (int j = 0; j < 8; ++j) acc8[j] = 0.f;
#pragma unroll 8
        for (int d = 0; d < 128; ++d) { const float x = ps[d] * pu[(size_t)d * D];
#pragma unroll
            for (int j = 0; j < 8; ++j) acc8[j] += pw[j * 128 + d] * x; }
        u32x4 o; o.x = cvt_pk_bf16(acc8[0], acc8[1]); o.y = cvt_pk_bf16(acc8[2], acc8[3]); o.z = cvt_pk_bf16(acc8[4], acc8[5]); o.w = cvt_pk_bf16(acc8[6], acc8[7]);
        *(u32x4*)(WSP(bf16_t, WS_WU) + (size_t)l * D * D + (size_t)(nb * 64 + C.lane) * D + g * 128 + kb * 8) = o;
    }
    if (C_BID == 0) { float* lbv = SMP(float, SM_LB);
        for (int c = C.tid; c < HW; c += NT) { const float b0 = CIN(7)[c], b1 = CIN(7)[HW + c], mx = fmaxf(b0, b1), e0 = expf(b0 - mx), e1 = expf(b1 - mx), s0 = e0 / (e0 + e1), s1 = e1 / (e0 + e1);
            lbv[c] = 0.f; lbv[HW + c] = fminf(fmaxf((s0 + s1) - s0, 0.f), 1.0f - 1e-6f); } }
}
__device__ __forceinline__ void phase_moe_weights(Ctx& C) {
    LAS float* scr = (LAS float*)(C.lds + C.wave * 16384);
    const int gw = C_BID * NW + C.wave, NGW = C_G * NW;
    constexpr int I_GU = (D / 64) * (DFF1 / 32), I_DN = (DFF1 / 64) * (D / 32);
    for (int it = gw; it < NEXP * (2 * I_GU + I_DN); it += NGW) {
        const int e = it / (2 * I_GU + I_DN); int r = it % (2 * I_GU + I_DN);
        if (r < 2 * I_GU) { const int isup = r >= I_GU ? 1 : 0; r -= isup * I_GU; const int nblk = DFF1 / 32, kb = r / nblk, nb = r % nblk, n0 = 32 * nb, drow = 256 * (n0 >> 7) + 128 * isup + (n0 & 127);
            tr_item8(CIN(16 + isup) + (size_t)e * D * DFF1, DFF1, 64 * kb, n0, C_WS + WS_MW + e * MW_GU_E + (size_t)drow * D + 64 * kb, D, F8_W, scr, C.lane); continue; }
        r -= 2 * I_GU;
        { const int nblk = D / 32, kb = r / nblk, nb = r % nblk;
          tr_item8(CIN(18) + (size_t)e * DFF1 * D, D, 64 * kb, 32 * nb, C_WS + WS_MWD + e * MW_DN_E + (size_t)(32 * nb) * DFF1 + 64 * kb, DFF1, F8_W, scr, C.lane); }
    }
}

__device__ __forceinline__ void phase_norm(Ctx& C, const float* xsrc, float* xdst, const float* w, bf16_t* hout, float* fout,
                                           const bf16_t* add, const int* slots, int nadd, const float* router, unsigned char* h8out = nullptr) {
    LAS float* RL = (LAS float*)C.lds;
    LAS int* cnt8 = (LAS int*)(C.lds + 32768);
    if (router) { for (int i = C.tid; i < D * NEXP / 4; i += NT) { const int c = i >> 1; ((LAS f32x4*)RL)[(i & 1) * 1024 + (4 * (c >> 8) + (c & 3)) * 64 + ((c & 255) >> 2)] = ((const f32x4*)router)[i]; } if (C.tid < 8) cnt8[C.tid] = 0; __syncthreads(); }
    float eps_ = EPS; asm volatile("" : "+s"(eps_));
    f32x4 wv[4];
#pragma unroll
    for (int j = 0; j < 4; ++j) wv[j] = ((const f32x4*)w)[64 * j + C.lane];
    for (int i = 0; i < 16; ++i) {
        const int row = C_BID * 128 + C.wave * 16 + i;
        const f32x4* xr = (const f32x4*)(xsrc + (size_t)row * D) + C.lane;
        f32x4 v[4];
#pragma unroll
        for (int j = 0; j < 4; ++j) v[j] = xr[64 * j];
        for (int a = 0; a < nadd; ++a) { const int ar = slots ? slots[2 * row + a] : row; const u32x2* p = (const u32x2*)(add + (size_t)ar * D) + C.lane;
#pragma unroll
            for (int j = 0; j < 4; ++j) { const u32x2 t = p[64 * j]; v[j][0] += bf_lo(t.x); v[j][1] += bf_hi(t.x); v[j][2] += bf_lo(t.y); v[j][3] += bf_hi(t.y); } }
        float ss = 0.f;
#pragma unroll
        for (int j = 0; j < 4; ++j) ss += (v[j][0] * v[j][0] + v[j][1] * v[j][1]) + (v[j][2] * v[j][2] + v[j][3] * v[j][3]);
        const float rs = 1.0f / sqrtf(wave_sum(ss, C.lane) * (1.0f / D) + eps_);
        if (xdst) { f32x4* xo = (f32x4*)(xdst + (size_t)row * D) + C.lane;
#pragma unroll
            for (int j = 0; j < 4; ++j) xo[64 * j] = v[j]; }
#pragma unroll
        for (int j = 0; j < 4; ++j) v[j] = v[j] * rs * wv[j];
        if (hout) { u32x2* ho = (u32x2*)(hout + (size_t)row * D) + C.lane;
#pragma unroll
            for (int j = 0; j < 4; ++j) { u32x2 t; t.x = cvt_pk_bf16(v[j][0], v[j][1]); t.y = cvt_pk_bf16(v[j][2], v[j][3]); ho[64 * j] = t; } }
        if (h8out) { const float lim = f8_limit(); unsigned* h8 = (unsigned*)(h8out + (size_t)row * D) + C.lane;
#pragma unroll
            for (int j = 0; j < 4; ++j) h8[64 * j] = pk4_fp8(v[j][0] * F8_H, v[j][1] * F8_H, v[j][2] * F8_H, v[j][3] * F8_H, lim); }
        if (fout) { f32x4* fo = (f32x4*)(fout + (size_t)row * D) + C.lane;
#pragma unroll
            for (int j = 0; j < 4; ++j) fo[64 * j] = v[j]; }
        if (router) {
            float lg[8];
#pragma unroll
            for (int e = 0; e < 8; ++e) lg[e] = 0.f;
#pragma unroll
            for (int j = 0; j < 4; ++j)
#pragma unroll
                for (int q = 0; q < 4; ++q) { const LAS f32x4* rp = (const LAS f32x4*)RL + (4 * j + q) * 64 + C.lane; const f32x4 r0 = rp[0], r1 = rp[1024]; const float hv = v[j][q];
                    lg[0] += hv * r0[0]; lg[1] += hv * r0[1]; lg[2] += hv * r0[2]; lg[3] += hv * r0[3]; lg[4] += hv * r1[0]; lg[5] += hv * r1[1]; lg[6] += hv * r1[2]; lg[7] += hv * r1[3]; }
#pragma unroll
            for (int e = 0; e < 8; ++e) lg[e] = wave_sum(lg[e], C.lane);
            int e1 = 0; float v1 = lg[0];
#pragma unroll
            for (int e = 1; e < 8; ++e) if (lg[e] > v1) { v1 = lg[e]; e1 = e; }
            int e2 = -1; float v2 = -3.0e38f;
#pragma unroll
            for (int e = 0; e < 8; ++e) if (e != e1 && lg[e] > v2) { v2 = lg[e]; e2 = e; }
            const float ex = expf(v2 - v1), w1 = 1.0f / (1.0f + ex), w2 = ex / (1.0f + ex);
            if (C.lane == 0) { SMP(int, SM_TOKE)[row] = e1 | (e2 << 8); SMP(f32x2, SM_TOKW)[row] = (f32x2){w1, w2}; atomicAdd((int*)cnt8 + e1, 1); atomicAdd((int*)cnt8 + e2, 1); }
        }
    }
    if (router) { __syncthreads(); if (C.tid < 8) SMP(int, SM_CNTWG)[C_BID * 8 + C.tid] = cnt8[C.tid]; }
}

constexpr int TAILSLOT = 256 * 256;
__device__ __forceinline__ void phase_norm_router(Ctx& C, float* x, const float* w, const bf16_t* add, unsigned char* h8out, const float* router) {
    LAS float* RL = (LAS float*)C.lds;
    LAS int* cnt8 = (LAS int*)(C.lds + 32768);
    for (int i = C.tid; i < D * NEXP / 4; i += NT) { const int c = i >> 1; ((LAS f32x4*)RL)[(i & 1) * 1024 + (4 * (c >> 8) + (c & 3)) * 64 + ((c & 255) >> 2)] = ((const f32x4*)router)[i]; }
    if (C.tid < 8) cnt8[C.tid] = 0;
    __syncthreads();
    float eps_ = EPS; asm volatile("" : "+s"(eps_));
    f32x4 wv[4];
#pragma unroll
    for (int j = 0; j < 4; ++j) wv[j] = ((const f32x4*)w)[64 * j + C.lane];
    const int row0 = C_BID * 128 + C.wave * 16;
    const bool b0 = C.lane & 1, b1 = C.lane & 2, b2 = C.lane & 4;
    f32x4 xv[4]; u32x2 av[4];
    { const f32x4* xr = (const f32x4*)(x + (size_t)row0 * D) + C.lane; const u32x2* p = (const u32x2*)(add + (size_t)row0 * D) + C.lane;
#pragma unroll
      for (int j = 0; j < 4; ++j) { xv[j] = xr[64 * j]; av[j] = p[64 * j]; } }
    for (int i = 0; i < 16; ++i) {
        const int row = row0 + i;
        f32x4 v[4];
#pragma unroll
        for (int j = 0; j < 4; ++j) { v[j] = xv[j]; v[j][0] += bf_lo(av[j].x); v[j][1] += bf_hi(av[j].x); v[j][2] += bf_lo(av[j].y); v[j][3] += bf_hi(av[j].y); }
        { const int nrow = row0 + min(i + 1, 15); const f32x4* xr = (const f32x4*)(x + (size_t)nrow * D) + C.lane; const u32x2* p = (const u32x2*)(add + (size_t)nrow * D) + C.lane;
#pragma unroll
          for (int j = 0; j < 4; ++j) { xv[j] = xr[64 * j]; av[j] = p[64 * j]; } }
        float ss = 0.f;
#pragma unroll
        for (int j = 0; j < 4; ++j) ss += (v[j][0] * v[j][0] + v[j][1] * v[j][1]) + (v[j][2] * v[j][2] + v[j][3] * v[j][3]);
        const float rs = 1.0f / sqrtf(wave_sum(ss, C.lane) * (1.0f / D) + eps_);
        { f32x4* xo = (f32x4*)(x + (size_t)row * D) + C.lane;
#pragma unroll
          for (int j = 0; j < 4; ++j) xo[64 * j] = v[j]; }
#pragma unroll
        for (int j = 0; j < 4; ++j) v[j] = v[j] * rs * wv[j];
        { const float lim = f8_limit(); unsigned* h8 = (unsigned*)(h8out + (size_t)row * D) + C.lane;
#pragma unroll
          for (int j = 0; j < 4; ++j) h8[64 * j] = pk4_fp8(v[j][0] * F8_H, v[j][1] * F8_H, v[j][2] * F8_H, v[j][3] * F8_H, lim); }
        f32x2 lg[4];
#pragma unroll
        for (int e = 0; e < 4; ++e) lg[e] = (f32x2){0.f, 0.f};
#pragma unroll
        for (int j = 0; j < 4; ++j)
#pragma unroll
            for (int q = 0; q < 4; ++q) { const LAS f32x4* rp = (const LAS f32x4*)RL + (4 * j + q) * 64 + C.lane; const f32x4 r0 = rp[0], r1 = rp[1024]; const f32x2 hv = (f32x2){v[j][q], v[j][q]};
                lg[0] = __builtin_elementwise_fma(hv, (f32x2){r0[0], r0[1]}, lg[0]); lg[1] = __builtin_elementwise_fma(hv, (f32x2){r0[2], r0[3]}, lg[1]);
                lg[2] = __builtin_elementwise_fma(hv, (f32x2){r1[0], r1[1]}, lg[2]); lg[3] = __builtin_elementwise_fma(hv, (f32x2){r1[2], r1[3]}, lg[3]); }
        float t4[4], t2[2], t1;
        { const float a[8] = {lg[0][0], lg[0][1], lg[1][0], lg[1][1], lg[2][0], lg[2][1], lg[3][0], lg[3][1]};
#pragma unroll
          for (int k = 0; k < 4; ++k) { const float send = b0 ? a[k] : a[k + 4], keep = b0 ? a[k + 4] : a[k]; t4[k] = keep + shfl_xor_l(send, 1, C.lane); } }
#pragma unroll
        for (int k = 0; k < 2; ++k) { const float send = b1 ? t4[k] : t4[k + 2], keep = b1 ? t4[k + 2] : t4[k]; t2[k] = keep + shfl_xor_l(send, 2, C.lane); }
        { const float send = b2 ? t2[0] : t2[1], keep = b2 ? t2[1] : t2[0]; t1 = keep + shfl_xor_l(send, 4, C.lane); }
        t1 += shfl_xor_l(t1, 8, C.lane); t1 += shfl_xor_l(t1, 16, C.lane); t1 += shfl_xor_l(t1, 32, C.lane);
        float lt[8];
#pragma unroll
        for (int e = 0; e < 8; ++e) lt[e] = __builtin_bit_cast(float, __builtin_amdgcn_readlane(__builtin_bit_cast(int, t1), ((e >> 2) & 1) | (((e >> 1) & 1) << 1) | ((e & 1) << 2)));
        int e1 = 0; float v1 = lt[0];
#pragma unroll
        for (int e = 1; e < 8; ++e) if (lt[e] > v1) { v1 = lt[e]; e1 = e; }
        int e2 = -1; float v2 = -3.0e38f;
#pragma unroll
        for (int e = 0; e < 8; ++e) if (e != e1 && lt[e] > v2) { v2 = lt[e]; e2 = e; }
        const float ex = expf(v2 - v1), w1 = 1.0f / (1.0f + ex), w2 = ex / (1.0f + ex);
        if (C.lane == 0) { SMP(int, SM_TOKE)[row] = e1 | (e2 << 8); SMP(f32x2, SM_TOKW)[row] = (f32x2){w1, w2}; atomicAdd((int*)cnt8 + e1, 1); atomicAdd((int*)cnt8 + e2, 1); }
    }
    __syncthreads();
    if (C.tid < 8) SMP(int, SM_CNTWG)[C_BID * 8 + C.tid] = cnt8[C.tid];
}
__device__ __forceinline__ void phase_final(Ctx& C, int mode, int nskip) {
    const int vb = C_BID - nskip, nwk = C_G - nskip; if (vb < 0) return;
    const float* w = CIN(19); float* xo = C_OUT; const bf16_t* dn = WSP(bf16_t, WS_DN1); const int* slots = SMP(int, SM_TOKS);
    float eps_ = EPS; asm volatile("" : "+s"(eps_));
    f32x4 wv[4];
#pragma unroll
    for (int j = 0; j < 4; ++j) wv[j] = ((const f32x4*)w)[64 * j + C.lane];
    for (int row = vb * NW + C.wave; row < M; row += nwk * NW) {
        const int s1 = slots[2 * row], s2 = slots[2 * row + 1];
        const bool tail = (s1 >= TAILSLOT) || (s2 >= TAILSLOT);
        if ((mode == 1) == tail) continue;
        f32x4* xr = (f32x4*)(xo + (size_t)row * D) + C.lane; const u32x2* p1 = (const u32x2*)(dn + (size_t)s1 * D) + C.lane; const u32x2* p2_ = (const u32x2*)(dn + (size_t)s2 * D) + C.lane;
        f32x4 v[4]; u32x2 a[4], b[4];
#pragma unroll
        for (int j = 0; j < 4; ++j) { v[j] = xr[64 * j]; a[j] = p1[64 * j]; b[j] = p2_[64 * j]; }
        float ss = 0.f;
#pragma unroll
        for (int j = 0; j < 4; ++j) { v[j][0] += bf_lo(a[j].x) + bf_lo(b[j].x); v[j][1] += bf_hi(a[j].x) + bf_hi(b[j].x); v[j][2] += bf_lo(a[j].y) + bf_lo(b[j].y); v[j][3] += bf_hi(a[j].y) + bf_hi(b[j].y);
            ss += (v[j][0] * v[j][0] + v[j][1] * v[j][1]) + (v[j][2] * v[j][2] + v[j][3] * v[j][3]); }
        const float rs = 1.0f / sqrtf(wave_sum(ss, C.lane) * (1.0f / D) + eps_);
#pragma unroll
        for (int j = 0; j < 4; ++j) xr[64 * j] = v[j] * rs * wv[j];
    }
}
__device__ __forceinline__ void phase_route(Ctx& C) {
    LAS int* tot = (LAS int*)C.lds; LAS int* bef = tot + 8; LAS int* base = tot + 16;
    const int* cw = SMP(int, SM_CNTWG);
    { LAS int* pt = tot + 32; LAS int* pb = pt + 512; const int e = C.tid & 7, part = C.tid >> 3; int t = 0, b = 0;
#pragma unroll
      for (int q = 0; q < 4; ++q) { const int g = part * 4 + q; const int c = (g < C_G) ? cw[g * 8 + e] : 0; t += c; b += (g < C_BID) ? c : 0; }
      pt[C.tid] = t; pb[C.tid] = b; }
    __syncthreads();
    if (C.tid < 8) { LAS int* pt = tot + 32; LAS int* pb = pt + 512; int t = 0, b = 0;
#pragma unroll 8
        for (int p = 0; p < 64; ++p) { t += pt[p * 8 + C.tid]; b += pb[p * 8 + C.tid]; }
        tot[C.tid] = t; bef[C.tid] = b; }
    __syncthreads();
    if (C.tid == 0) { int s = 0; for (int e = 0; e < 8; ++e) { base[e] = s; s += ((tot[e] + 255) >> 8) << 8; } base[8] = s; }
    __syncthreads();
    int* rowidx = SMP(int, SM_ROWIDX); float* rowsc = SMP(float, SM_ROWSC);
    if (C_BID == 0) { const int ntiles = base[8] >> 8;
        for (int t = C.tid; t < MAXT; t += NT) { int e = 0; for (int q = 1; q < 8; ++q) e += (base[q] <= t * 256) ? 1 : 0; SMP(int, SM_TILEEXP)[t] = (t < ntiles) ? e : 0; }
        if (C.tid == 0) SMP(int, SM_NT)[0] = ntiles; }
    if (C_BID < 8) { const int e = C_BID; for (int s = base[e] + tot[e] + C.tid; s < base[e + 1]; s += NT) { rowidx[s] = 0; rowsc[s] = 0.f; } }
    if (C.wave == 0) {
        int run[8];
#pragma unroll
        for (int e = 0; e < 8; ++e) run[e] = base[e] + bef[e];
        for (int p = 0; p < 2; ++p) {
            const int tok = C_BID * 128 + p * 64 + C.lane; const int ee = SMP(int, SM_TOKE)[tok], e1 = ee & 255, e2 = ee >> 8; const f32x2 tw = SMP(f32x2, SM_TOKW)[tok];
            int s1 = 0, s2 = 0; const unsigned long long below = (1ull << C.lane) - 1ull;
#pragma unroll
            for (int e = 0; e < 8; ++e) { const bool has = (e1 == e) || (e2 == e); const unsigned long long m = __ballot(has); const int pos = run[e] + __popcll(m & below);
                if (e1 == e) s1 = pos; if (e2 == e) s2 = pos; run[e] += __popcll(m); }
            rowidx[s1] = tok; rowsc[s1] = tw.x; rowidx[s2] = tok; rowsc[s2] = tw.y; SMP(int, SM_TOKS)[2 * tok] = s1; SMP(int, SM_TOKS)[2 * tok + 1] = s2;
        }
    }
}
__device__ __forceinline__ void phase_gather(Ctx& C) {
    const int nslots = __hip_atomic_load(SMP(int, SM_NT), __ATOMIC_RELAXED, __HIP_MEMORY_SCOPE_AGENT) * 256; const int* rowidx = SMP(int, SM_ROWIDX);
    for (int s = C_BID * NW + C.wave; s < nslots; s += C_G * NW * 2) {
        const int s2 = s + C_G * NW; const bool has2 = s2 < nslots;
        const u32x4 a = *((const u32x4*)(C_WS + WS_H + (size_t)rowidx[s] * D) + C.lane);
        u32x4 b = a; if (has2) b = *((const u32x4*)(C_WS + WS_H + (size_t)rowidx[s2] * D) + C.lane);
        *((u32x4*)(C_WS + WS_H2G + (size_t)s * D) + C.lane) = a;
        if (has2) *((u32x4*)(C_WS + WS_H2G + (size_t)s2 * D) + C.lane) = b; }
}
__device__ __forceinline__ void phase_pool(Ctx& C) {
    const bf16_t* U = WSP(bf16_t, WS_U); bf16_t* A2 = WSP(bf16_t, WS_A2);
    const int win = 2 << (C.lane >> 4);
    for (int run = C_BID * NW + C.wave; run < M / 16; run += C_G * NW) {
        const int t0 = run * 16, p0 = t0 & (SEQ - 1);
        u32x4 cu[16], ou[16];
#pragma unroll
        for (int tt = 0; tt < 16; ++tt) cu[tt] = *((const u32x4*)(U + (size_t)(t0 + tt) * PW) + C.lane);
#pragma unroll
        for (int tt = 0; tt < 16; ++tt) { ou[tt] = (u32x4){0u, 0u, 0u, 0u}; if (p0 + tt - win + 1 >= 0) ou[tt] = *((const u32x4*)(U + (size_t)(t0 + tt - win + 1) * PW) + C.lane); }
        float s[8];
#pragma unroll
        for (int q = 0; q < 8; ++q) s[q] = 0.f;
        for (int h = 1; h < 16; ++h) if (h < win && p0 - h >= 0) { const u32x4 t = *((const u32x4*)(U + (size_t)(t0 - h) * PW) + C.lane);
            s[0] += bf_lo(t.x); s[1] += bf_hi(t.x); s[2] += bf_lo(t.y); s[3] += bf_hi(t.y); s[4] += bf_lo(t.z); s[5] += bf_hi(t.z); s[6] += bf_lo(t.w); s[7] += bf_hi(t.w); }
#pragma unroll
        for (int tt = 0; tt < 16; ++tt) {
            const int t = t0 + tt, p = p0 + tt; const u32x4 c4 = cu[tt], o = ou[tt];
            const float c[8] = {bf_lo(c4.x), bf_hi(c4.x), bf_lo(c4.y), bf_hi(c4.y), bf_lo(c4.z), bf_hi(c4.z), bf_lo(c4.w), bf_hi(c4.w)};
#pragma unroll
            for (int q = 0; q < 8; ++q) s[q] += c[q];
            const float inv = 1.0f / (float)((p + 1) < win ? (p + 1) : win);
            u32x4 r; r.x = cvt_pk_bf16(s[0] * inv - c[0], s[1] * inv - c[1]); r.y = cvt_pk_bf16(s[2] * inv - c[2], s[3] * inv - c[3]);
            r.z = cvt_pk_bf16(s[4] * inv - c[4], s[5] * inv - c[5]); r.w = cvt_pk_bf16(s[6] * inv - c[6], s[7] * inv - c[7]);
            *((u32x4*)(A2 + (size_t)t * D) + C.lane) = r;
            s[0] -= bf_lo(o.x); s[1] -= bf_hi(o.x); s[2] -= bf_lo(o.y); s[3] -= bf_hi(o.y); s[4] -= bf_lo(o.z); s[5] -= bf_hi(o.z); s[6] -= bf_lo(o.w); s[7] -= bf_hi(o.w);
        }
    }
}

constexpr int HQ_QT = 0, HQ_KH = 17408, HQ_KT = 34816, HQ_VT = 53248, HQ_ST = 71680, HQ_PP = 106496, HQ_TS = 115712, HQ_DC = 117760, HQ_ER = 118272, HQ_NS = 118784;
constexpr int HQ_OT = 0, OTP = 528;
static_assert(64 * OTP <= HQ_KT, "output staging fits over QT | KH");
constexpr int LD128 = 272, LD64 = 144;
template <bool OUT>
__device__ __forceinline__ void hgrn_item(Ctx& C, int item, const float* nw  ) {
    const int bh = item >> 5, j = item & 31, hh = bh & 3, row0 = (bh >> 2) * SEQ + j * 512;
    const int tid = C.tid, lane = C.lane, w = C.wave, fr = lane & 15, fq = lane >> 4;
    const int pk = tid & 127, pi = tid >> 7;
    LAS unsigned char* L = C.lds;
    const float* LFp = WSP(float, WS_LF) + hh * 128 + pk; const bf16_t* Qp = WSP(bf16_t, WS_Q) + hh * 128 + pk; const bf16_t* Vp = WSP(bf16_t, WS_V) + hh * 128 + pk;
    f32x4 acc[8];
    if (OUT) { const float* si = WSP(float, WS_SI) + (size_t)item * 16384;
#pragma unroll
        for (int vj = 0; vj < 8; ++vj)
#pragma unroll
            for (int r = 0; r < 4; ++r) acc[vj][r] = si[(16 * w + 4 * fq + r) * 128 + 16 * vj + fr];
    } else {
#pragma unroll
        for (int vj = 0; vj < 8; ++vj) acc[vj] = (f32x4){0.f, 0.f, 0.f, 0.f};
    }
    float gtot = 0.f; float lim80 = 80.f, eps_ = EPS; asm volatile("" : "+s"(lim80), "+s"(eps_));
    float lf[16]; bf16_t vv[16], qv[16];
#define HG_ISSUE(cc) do { const int rbn_ = row0 + (cc) * 64 + 16 * pi; _Pragma("unroll") for (int t = 0; t < 16; ++t) { lf[t] = LFp[(size_t)(rbn_ + t) * HW]; vv[t] = Vp[(size_t)(rbn_ + t) * HW]; if (OUT) qv[t] = Qp[(size_t)(rbn_ + t) * HW]; } } while (0)
    HG_ISSUE(0);
    for (int c = 0; c < 8; ++c) {
        const int m0 = row0 + c * 64;
        float Lc[16]; { float run = 0.f;
#pragma unroll
            for (int t = 0; t < 16; ++t) { run += lf[t]; Lc[t] = run; } }
        ((LAS float*)(L + HQ_TS))[pi * 128 + pk] = Lc[15];
        __syncthreads();
        const float t0 = ((LAS float*)(L + HQ_TS))[pk], t1 = ((LAS float*)(L + HQ_TS))[128 + pk], t2 = ((LAS float*)(L + HQ_TS))[256 + pk], t3 = ((LAS float*)(L + HQ_TS))[384 + pk];
        const float P2 = t0 + t1, P4 = (t0 + t1) + (t2 + t3), Pi = (pi > 0 ? t0 : 0.f) + (pi > 1 ? t1 : 0.f) + (pi > 2 ? t2 : 0.f);
        if (pi == 0) { ((LAS float*)(L + HQ_DC))[pk] = fast_exp(P4); ((LAS float*)(L + HQ_ER))[pk] = fast_exp(P2); gtot += P4; }
        unsigned ktp[8], vtp[8];
#pragma unroll
        for (int t = 0; t < 16; t += 2) {
            float kt2[2];
#pragma unroll
            for (int h = 0; h < 2; ++h) { const int tt = t + h; const float Gt = Pi + Lc[tt]; const float kk = 1.0f - fast_exp(lf[tt]);
                const float a = __builtin_amdgcn_fmed3f(Gt - P2, -lim80, lim80);
                if (OUT) { const float qf = bf2f(qv[tt]); const int trow = 16 * pi + tt;
                    *(LAS bf16_t*)(L + HQ_QT + trow * LD128 + pk * 2) = (bf16_t)(cvt_pk_bf16(qf * fast_exp(a), 0.f) & 0xffffu);
                    *(LAS bf16_t*)(L + HQ_KH + trow * LD128 + pk * 2) = (bf16_t)(cvt_pk_bf16(kk * fast_exp(-a), 0.f) & 0xffffu); }
                kt2[h] = kk * fast_exp(P4 - Gt); }
            ktp[t >> 1] = cvt_pk_bf16(kt2[0], kt2[1]); vtp[t >> 1] = (unsigned)vv[t] | ((unsigned)vv[t + 1] << 16);
        }
        { LAS u32x4* kd = (LAS u32x4*)(L + HQ_KT + pk * LD64 + pi * 32); kd[0] = (u32x4){ktp[0], ktp[1], ktp[2], ktp[3]}; kd[1] = (u32x4){ktp[4], ktp[5], ktp[6], ktp[7]};
          LAS u32x4* vd = (LAS u32x4*)(L + HQ_VT + pk * LD64 + pi * 32); vd[0] = (u32x4){vtp[0], vtp[1], vtp[2], vtp[3]}; vd[1] = (u32x4){vtp[4], vtp[5], vtp[6], vtp[7]}; }
        __syncthreads();
        bf16x8 aq[4]; u32x4 gw0, gw1; f32x4 nv[4];
        if (OUT) { const int v0 = 16 * (tid & 7);
#pragma unroll
            for (int i = 0; i < 4; ++i) nv[i] = *(const f32x4*)(nw + v0 + 4 * i); }
        if (c < 7) HG_ISSUE(c + 1);
        const int ti = w >> 1;
        if (OUT) {
            const f32x4 er = *(const LAS f32x4*)(L + HQ_ER + (16 * w + 4 * fq) * 4);
#pragma unroll
            for (int vj = 0; vj < 8; ++vj) { u32x2 p; p.x = cvt_pk_bf16(acc[vj][0] * er[0], acc[vj][1] * er[1]); p.y = cvt_pk_bf16(acc[vj][2] * er[2], acc[vj][3] * er[3]);
                *(LAS u32x2*)(L + HQ_ST + (16 * vj + fr) * LD128 + (16 * w + 4 * fq) * 2) = p; }
#pragma unroll
            for (int k2 = 0; k2 < 4; ++k2) aq[k2] = *(const LAS bf16x8*)(L + HQ_QT + (16 * ti + fr) * LD128 + (32 * k2 + 8 * fq) * 2);
#pragma unroll
            for (int q = 0; q < 2; ++q) { const int tj = 2 * (w & 1) + q; f32x4 sc = (f32x4){0.f, 0.f, 0.f, 0.f};
#pragma unroll
                for (int k2 = 0; k2 < 4; ++k2) { const bf16x8 bk = *(const LAS bf16x8*)(L + HQ_KH + (16 * tj + fr) * LD128 + (32 * k2 + 8 * fq) * 2); sc = __builtin_amdgcn_mfma_f32_16x16x32_bf16(aq[k2], bk, sc, 0, 0, 0); }
#pragma unroll
                for (int r = 0; r < 4; ++r) { const int t = 16 * ti + 4 * fq + r, s = 16 * tj + fr; const float pv = (s <= t) ? sc[r] : 0.f;
                    *(LAS bf16_t*)(L + HQ_PP + t * LD64 + s * 2) = (bf16_t)(cvt_pk_bf16(pv, 0.f) & 0xffffu); } }
            { const bf16_t* gp = WSP(bf16_t, WS_GG) + (size_t)(m0 + (tid >> 3)) * HW + hh * 128 + 16 * (tid & 7); gw0 = *(const u32x4*)gp; gw1 = *(const u32x4*)(gp + 8); }
            __syncthreads();
            bf16x8 ap[2];
#pragma unroll
            for (int k2 = 0; k2 < 2; ++k2) ap[k2] = *(const LAS bf16x8*)(L + HQ_PP + (16 * ti + fr) * LD64 + (32 * k2 + 8 * fq) * 2);
            float ss[4] = {0.f, 0.f, 0.f, 0.f};
#pragma unroll
            for (int q = 0; q < 4; ++q) { const int vj = 4 * (w & 1) + q; f32x4 ov = (f32x4){0.f, 0.f, 0.f, 0.f};
#pragma unroll
                for (int k2 = 0; k2 < 2; ++k2) { const bf16x8 bv = *(const LAS bf16x8*)(L + HQ_VT + (16 * vj + fr) * LD64 + (32 * k2 + 8 * fq) * 2); ov = __builtin_amdgcn_mfma_f32_16x16x32_bf16(ap[k2], bv, ov, 0, 0, 0); }
#pragma unroll
                for (int k2 = 0; k2 < 4; ++k2) { const bf16x8 bs = *(const LAS bf16x8*)(L + HQ_ST + (16 * vj + fr) * LD128 + (32 * k2 + 8 * fq) * 2); ov = __builtin_amdgcn_mfma_f32_16x16x32_bf16(aq[k2], bs, ov, 0, 0, 0); }
#pragma unroll
                for (int r = 0; r < 4; ++r) { *(LAS float*)(L + HQ_OT + (16 * ti + 4 * fq + r) * OTP + (16 * vj + fr) * 4) = ov[r]; ss[r] += ov[r] * ov[r]; } }
#pragma unroll
            for (int r = 0; r < 4; ++r) { float s = ss[r]; s += shfl_xor_l(s, 1, lane); s += shfl_xor_l(s, 2, lane); s += shfl_xor_l(s, 4, lane); s += shfl_xor_l(s, 8, lane);
                if (fr == 0) ((LAS float*)(L + HQ_NS))[(16 * ti + 4 * fq + r) * 2 + (w & 1)] = s; }
        }
        {
            bf16x8 ak[2];
#pragma unroll
            for (int k2 = 0; k2 < 2; ++k2) ak[k2] = *(const LAS bf16x8*)(L + HQ_KT + (16 * w + fr) * LD64 + (32 * k2 + 8 * fq) * 2);
            const f32x4 dc = *(const LAS f32x4*)(L + HQ_DC + (16 * w + 4 * fq) * 4);
#pragma unroll
            for (int vj = 0; vj < 8; ++vj) { f32x4 a = acc[vj] * dc;
#pragma unroll
                for (int k2 = 0; k2 < 2; ++k2) { const bf16x8 bv = *(const LAS bf16x8*)(L + HQ_VT + (16 * vj + fr) * LD64 + (32 * k2 + 8 * fq) * 2); a = __builtin_amdgcn_mfma_f32_16x16x32_bf16(ak[k2], bv, a, 0, 0, 0); }
                acc[vj] = a; }
        }
        __syncthreads();
        if (OUT) {
            { const int t = tid >> 3, v0 = 16 * (tid & 7);
              const float tot = ((LAS float*)(L + HQ_NS))[t * 2] + ((LAS float*)(L + HQ_NS))[t * 2 + 1]; const float rs = 1.0f / sqrtf(tot * (1.0f / 128.0f) + eps_);
              f32x4 ox[4];
#pragma unroll
              for (int i = 0; i < 4; ++i) ox[i] = *(const LAS f32x4*)(L + HQ_OT + t * OTP + (v0 + 4 * i) * 4);
              const float g[16] = {bf_lo(gw0.x), bf_hi(gw0.x), bf_lo(gw0.y), bf_hi(gw0.y), bf_lo(gw0.z), bf_hi(gw0.z), bf_lo(gw0.w), bf_hi(gw0.w), bf_lo(gw1.x), bf_hi(gw1.x), bf_lo(gw1.y), bf_hi(gw1.y), bf_lo(gw1.z), bf_hi(gw1.z), bf_lo(gw1.w), bf_hi(gw1.w)};
              float y[16];
#pragma unroll
              for (int i = 0; i < 4; ++i)
#pragma unroll
                  for (int e = 0; e < 4; ++e) y[4 * i + e] = ox[i][e] * rs * nv[i][e] * g[4 * i + e];
              u32x4 w0, w1; w0.x = cvt_pk_bf16(y[0], y[1]); w0.y = cvt_pk_bf16(y[2], y[3]); w0.z = cvt_pk_bf16(y[4], y[5]); w0.w = cvt_pk_bf16(y[6], y[7]);
              w1.x = cvt_pk_bf16(y[8], y[9]); w1.y = cvt_pk_bf16(y[10], y[11]); w1.z = cvt_pk_bf16(y[12], y[13]); w1.w = cvt_pk_bf16(y[14], y[15]);
              bf16_t* op = WSP(bf16_t, WS_A2) + (size_t)(m0 + t) * D + 512 + hh * 128 + v0; *(u32x4*)op = w0; *(u32x4*)(op + 8) = w1; }
        }
    }
    if (!OUT) { float* sl = WSP(float, WS_SL) + (size_t)item * 16384;
#pragma unroll
        for (int vj = 0; vj < 8; ++vj)
#pragma unroll
            for (int r = 0; r < 4; ++r) sl[(16 * w + 4 * fq + r) * 128 + 16 * vj + fr] = acc[vj][r];
        if (pi == 0) SMP(float, SM_DT)[item * 128 + pk] = fast_exp(gtot); }
}
__device__ __forceinline__ void phase_scan(Ctx& C) {
    const float* SL = WSP(float, WS_SL); float* SI = WSP(float, WS_SI); const float* DT = SMP(float, SM_DT);
    for (int gid = C_BID * NT + C.tid; gid < 8 * 16384; gid += C_G * NT) {
        const int bh = gid >> 14, e = gid & 16383, k = e >> 7; float s = 0.f;
        float sl[31], dt[31];
#pragma unroll
        for (int j = 0; j < 31; ++j) { const size_t it = (size_t)(bh * 32 + j); sl[j] = SL[it * 16384 + e]; dt[j] = DT[it * 128 + k]; }
#pragma unroll
        for (int j = 0; j < 32; ++j) { SI[(size_t)(bh * 32 + j) * 16384 + e] = s; if (j < 31) s = dt[j] * s + sl[j]; }
    }
}

constexpr int NSTAGES = 26;

__global__ void __launch_bounds__(NT, 2) fwd(Args a) {
    extern __shared__ __attribute__((aligned(16))) unsigned char lds_raw[];
    Ctx C;
    C.lds = (LAS unsigned char*)lds_raw; C.tid = threadIdx.x; C.lane = C.tid & 63; C.wave = __builtin_amdgcn_readfirstlane(C.tid >> 6);
    int wave_s = C.wave;
    C.a = (const CAS Args*)__builtin_amdgcn_kernarg_segment_ptr();
    volatile LAS unsigned* MISC = (volatile LAS unsigned*)(C.lds + MISC_OFF);
    if (C.tid < 64) MISC[C.tid] = 0u;
    __syncthreads();
#if N_LAUNCHES == 1
    const int lo = 0, hi = NSTAGES;
    (void)xcd_barrier_post((unsigned*)(C_WS + WS_CTL) + CW_BAR, MISC + 8, C.tid);
#define SEAM() do { if (st + 1 < NSTAGES) { XcdBarrier bar_; bar_.bar = (unsigned*)(C_WS + WS_CTL) + CW_BAR; bar_.x = xb_xcc_id(); bar_.st = (volatile LAS unsigned*)(C.lds + MISC_OFF) + 8; unsigned mb_ = ~0u; asm volatile("" : "+s"(mb_), "+s"(wave_s)); const int tid_b = wave_s * 64 + (int)__builtin_amdgcn_mbcnt_hi(mb_, __builtin_amdgcn_mbcnt_lo(mb_, 0u)); xcd_barrier(bar_, tid_b); } } while (0)
#else
    const int lo = C.a->lo, hi = C.a->hi;
#define SEAM() do { } while (0)
#endif
    int st = 0;
#define STAGE_BEGIN(k) if (st >= lo && st < hi) { { unsigned m_ = ~0u; asm volatile("" : "+s"(m_), "+s"(wave_s)); C.lane = (int)__builtin_amdgcn_mbcnt_hi(m_, __builtin_amdgcn_mbcnt_lo(m_, 0u)); C.wave = wave_s; C.tid = wave_s * 64 + C.lane; } asm volatile("" : "+s"(C.a)); asm volatile("" : "+s"(C.lds)); C.G = gridDim.x; C.bid = blockIdx.x; asm volatile("" : "+s"(C.G), "+s"(C.bid));
#define STAGE_END } if (st >= lo && st < hi) { SEAM(); } ++st;
#define Hb WSP(bf16_t, WS_H)
    constexpr unsigned T1K = 256u * 1024 * 2;


    for (int l = 0; l < 2; ++l) {
        STAGE_BEGIN(1) if (l == 0) { phase_prologue(C); __syncthreads(); }
            phase_norm(C, l == 0 ? CIN(0) : C_OUT, l == 0 ? nullptr : C_OUT, CIN(1) + l * D, Hb, nullptr, WSP(bf16_t, WS_DN0), nullptr, l, nullptr, C_WS + WS_H8); STAGE_END
        STAGE_BEGIN(2) {
            {
                pg8::Gemm g{(const char*)C_WS, D, D, D};
                GridOrder S{(unsigned)WS_H, (unsigned)WS_WIN + (unsigned)l * (INC * D * 2), T1K, T1K, M / 256, (INC - NGATE) / 256, C_G, C_BID};
                EpiIn E{C_WS, CIN(3) + l * NGATE, l};
                pg8::gemm_phase<false>(C.lds, g, S, E, C.tid);
            }
            {
                pg8::Gemm g{(const char*)C_WS, D / 2, D / 2, D / 2};
                GridOrder S{(unsigned)WS_H8, (unsigned)WS_WG8 + (unsigned)l * (NGATE * D), 256u * D, 256u * D, M / 256, NGATE / 256, C_G, C_BID};
                EpiGate8 E{C_WS, CIN(3) + l * NGATE, 1.0f / (F8_H * F8_W)};
                pg8::gemm_phase<true>(C.lds, g, S, E, C.tid);
            }
        } STAGE_END
        STAGE_BEGIN(3) phase_pool(C); __syncthreads(); for (int it = C_BID; it < 256; it += C_G) hgrn_item<false>(C, it, nullptr); STAGE_END
        STAGE_BEGIN(4) phase_scan(C); STAGE_END
        STAGE_BEGIN(5) for (int it = C_BID; it < 256; it += C_G) hgrn_item<true>(C, it, CIN(8) + l * 128); STAGE_END
        STAGE_BEGIN(6) {
            pg8::Gemm g{(const char*)C_WS, D, D, 512};
            UOrder S{(unsigned)WS_A2, (unsigned)WS_WU + (unsigned)l * (D * D * 2), C_G, C_BID};
            EpiU E{C_WS};
            pg8::gemm_phase<false>(C.lds, g, S, E, C.tid);
        } STAGE_END
        STAGE_BEGIN(7) {
            pg8::Gemm g{(const char*)C_WS, D, D, D};
            GridOrder S{(unsigned)WS_H, (unsigned)WS_WOUT + (unsigned)l * (D * D * 2), T1K, T1K, M / 256, D / 256, C_G, C_BID};
            EpiRow E{WSP(bf16_t, WS_MO), D, nullptr, 1.0f};
            pg8::gemm_phase<false>(C.lds, g, S, E, C.tid);
        } STAGE_END
        STAGE_BEGIN(8) if (l == 0) phase_norm(C, CIN(0), C_OUT, CIN(11), Hb, nullptr, WSP(bf16_t, WS_MO), nullptr, 1, nullptr, nullptr);
            else { phase_norm_router(C, C_OUT, CIN(11) + D, WSP(bf16_t, WS_MO), C_WS + WS_H, CIN(15));     __syncthreads(); phase_moe_weights(C); } STAGE_END
        if (l == 1) {
            STAGE_BEGIN(9) phase_route(C); STAGE_END
            STAGE_BEGIN(10) phase_gather(C); STAGE_END
        }
        if (l == 0) {
            STAGE_BEGIN(11) {
                pg8::Gemm g{(const char*)C_WS, D, D, D};
                GuOrder S{(unsigned)WS_H, (unsigned)WS_DGU, nullptr, 0u, T1K, 0, 128, DFF0 / 128, C_G, C_BID};
                EpiSwi E{WSP(bf16_t, WS_ACT0), DFF0};
                pg8::gemm_phase<false>(C.lds, g, S, E, C.tid);
            } STAGE_END
            STAGE_BEGIN(12) {
                pg8::Gemm g{(const char*)C_WS, DFF0, DFF0, DFF0};
                DownOrder S{(unsigned)WS_ACT0, (unsigned)WS_DDN, nullptr, 0u, 256u * DFF0 * 2u, 0, 128, C_G, C_BID};
                EpiRow E{WSP(bf16_t, WS_DN0), D, nullptr, 1.0f};
                pg8::gemm_phase<false>(C.lds, g, S, E, C.tid);
            } STAGE_END
        } else {
            for (int gi = 0; gi < MOE_NG; ++gi) {
#define MOE_PARAMS() const int* texp = SMP(int, SM_TILEEXP); const int ntl = __builtin_amdgcn_readfirstlane(__hip_atomic_load(SMP(int, SM_NT), __ATOMIC_RELAXED, __HIP_MEMORY_SCOPE_AGENT)); \
                const int t0 = gi * MOE_G0; int nT = gi == 0 ? (ntl < MOE_G0 ? ntl : MOE_G0) : (ntl - MOE_G0); nT = nT < 0 ? 0 : nT;
                STAGE_BEGIN(14) {
                    MOE_PARAMS()
                    pg8::Gemm g{(const char*)C_WS, D / 2, D / 2, D / 2};
                    GuOrder S{(unsigned)WS_H2G, (unsigned)WS_MW, texp, (unsigned)MW_GU_E, 256u * D, t0, nT, DFF1 / 128, C_G, C_BID};
                    EpiSwi8 E{C_WS + WS_ACT1, DFF1, 1.0f / (F8_H * F8_W), F8_A};
                    pg8::gemm_phase<true>(C.lds, g, S, E, C.tid);
                } STAGE_END
                STAGE_BEGIN(15) {
                    MOE_PARAMS()
                    const int nTd = nT > 128 ? 128 : nT;
                    pg8::Gemm g{(const char*)C_WS, DFF1 / 2, DFF1 / 2, DFF1 / 2};
                    DownOrder S{(unsigned)WS_ACT1, (unsigned)WS_MWD, texp, (unsigned)MW_DN_E, 256u * DFF1, t0, nTd, C_G, C_BID};
                    EpiRow E{WSP(bf16_t, WS_DN1), D, SMP(float, SM_ROWSC), 1.0f / (F8_A * F8_W)};
                    pg8::gemm_phase<true>(C.lds, g, S, E, C.tid);
                } STAGE_END
            }
        }
    }
    STAGE_BEGIN(16) {
        const int* texp = SMP(int, SM_TILEEXP); const int ntl = __builtin_amdgcn_readfirstlane(__hip_atomic_load(SMP(int, SM_NT), __ATOMIC_RELAXED, __HIP_MEMORY_SCOPE_AGENT));
        const int nTt = ntl > 256 ? ntl - 256 : 0;
        {
            pg8::Gemm g{(const char*)C_WS, DFF1 / 2, DFF1 / 2, DFF1 / 2};
            DownOrder S{(unsigned)WS_ACT1 + 128u * (256u * DFF1), (unsigned)WS_MWD, texp, (unsigned)MW_DN_E, 256u * DFF1, 256, nTt, C_G, C_BID};
            EpiRow E{WSP(bf16_t, WS_DN1), D, SMP(float, SM_ROWSC), 1.0f / (F8_A * F8_W)};
            pg8::gemm_phase<true>(C.lds, g, S, E, C.tid);
        }
        phase_final(C, 1, nTt * 4);
    } STAGE_END
    STAGE_BEGIN(13) phase_final(C, 2, 0); STAGE_END
}


extern "C" void kernel_launch(void* const* d_in, const int* in_sizes, int n_in, void* d_out, int out_size, void* d_ws, size_t ws_size, hipStream_t stream) {
    static int grid = 0;
    if (grid == 0) {
        if (n_in != 20 || in_sizes[0] != M * D || out_size != M * D || ws_size < WS_END) { fprintf(stderr, "kernel_launch: unexpected sizes (n_in %d, out %d, ws %zu < %zu)\n", n_in, out_size, ws_size, (size_t)WS_END); grid = -1; return; }
        int dev = 0, cus = 0;
        if (hipGetDevice(&dev) != hipSuccess || hipDeviceGetAttribute(&cus, hipDeviceAttributeMultiprocessorCount, dev) != hipSuccess) { grid = -1; return; }
        if (hipFuncSetAttribute((const void*)fwd, hipFuncAttributeMaxDynamicSharedMemorySize, LDS_BYTES) != hipSuccess) { fprintf(stderr, "kernel_launch: hipFuncSetAttribute failed\n"); grid = -1; return; }
        int per_cu = 0;
        if (hipOccupancyMaxActiveBlocksPerMultiprocessor(&per_cu, (const void*)fwd, NT, LDS_BYTES) != hipSuccess || per_cu < 1) fprintf(stderr, "kernel_launch: occupancy query reports %d blocks per CU\n", per_cu);
        (void)hipGetLastError();
        if (cus != 256) { fprintf(stderr, "kernel_launch: built for a 256-CU device, found %d\n", cus); grid = -1; return; }
        grid = cus;
    }
    if (grid < 0) return;
    if (hipMemsetAsync((char*)d_ws + WS_CTL, 0, CTL_BYTES, stream) != hipSuccess) return;
    Args a{};
    for (int i = 0; i < 20; ++i) a.in[i] = (const float*)d_in[i];
    a.out = (float*)d_out; a.ws = (unsigned char*)d_ws;
#if N_LAUNCHES == 1
    a.lo = 0; a.hi = NSTAGES;
    hipLaunchKernelGGL(fwd, dim3(grid), dim3(NT), LDS_BYTES, stream, a);
#else
    for (int s = 0; s < NSTAGES; ++s) { a.lo = s; a.hi = s + 1; hipLaunchKernelGGL(fwd, dim3(grid), dim3(NT), LDS_BYTES, stream, a); }

#endif
}
```

```cpp
#include <hip/hip_runtime.h>
#include <cstdio>
#include <cstdint>

#ifndef N_LAUNCHES
#define N_LAUNCHES 1
#endif

#define GAS __attribute__((address_space(1)))
#define LAS __attribute__((address_space(3)))
typedef unsigned short bf16_t;
typedef short bf16x8 __attribute__((ext_vector_type(8)));
typedef float f32x4 __attribute__((ext_vector_type(4)));
typedef float f32x2 __attribute__((ext_vector_type(2)));
typedef unsigned u32x4 __attribute__((ext_vector_type(4)));
typedef unsigned u32x2 __attribute__((ext_vector_type(2)));
typedef int i32x4 __attribute__((ext_vector_type(4)));
typedef int i32x8 __attribute__((ext_vector_type(8)));

constexpr int BATCH = 2, SEQ = 16384, D = 1024, M = BATCH * SEQ;
constexpr int PW = 512, HW = 512, INC = 4608, NGATE = 2048;
constexpr int DFF0 = 2816, DFF1 = 3584, NEXP = 8;
constexpr float EPS = 1e-6f;
constexpr int MAXTILES = 320;
constexpr int MAXSLOTS = MAXTILES * 256;

typedef __bf16 bf16x2_t __attribute__((ext_vector_type(2)));
__device__ __forceinline__ unsigned cvt_pk_bf16(float lo, float hi) { const bf16x2_t v = __builtin_convertvector((f32x2){lo, hi}, bf16x2_t); return __builtin_bit_cast(unsigned, v); }
__device__ __forceinline__ float f8_limit() { float l = 448.0f; asm volatile("" : "+s"(l)); return l; }
__device__ __forceinline__ float clamp_f8(float x, float lim) { return __builtin_amdgcn_fmed3f(x, -lim, lim); }
__device__ __forceinline__ unsigned pk4_fp8(float a, float b, float c, float d, float lim) {
    unsigned w = 0u; w = __builtin_amdgcn_cvt_pk_fp8_f32(clamp_f8(a, lim), clamp_f8(b, lim), w, false); w = __builtin_amdgcn_cvt_pk_fp8_f32(clamp_f8(c, lim), clamp_f8(d, lim), w, true); return w; }
__device__ __forceinline__ float bf_lo(unsigned w) { return __uint_as_float(w << 16); }
__device__ __forceinline__ float bf_hi(unsigned w) { return __uint_as_float(w & 0xffff0000u); }
__device__ __forceinline__ float bf2f(bf16_t b) { return __uint_as_float(((unsigned)b) << 16); }
__device__ __forceinline__ float fast_rcp(float x) { return __builtin_amdgcn_rcpf(x); }
__device__ __forceinline__ float fast_exp(float x) { return __builtin_amdgcn_exp2f(x * 1.44269504088896f); }
__device__ __forceinline__ float sigmoidf_(float x) { return fast_rcp(1.0f + fast_exp(-x)); }
__device__ __forceinline__ float siluf_(float x) { return x * sigmoidf_(x); }
__device__ __forceinline__ f32x2 sigmoid2(f32x2 x) { const f32x2 t = x * (f32x2){-1.44269504088896f, -1.44269504088896f}; f32x2 e; e.x = __builtin_amdgcn_exp2f(t.x); e.y = __builtin_amdgcn_exp2f(t.y);
    const f32x2 d = e + (f32x2){1.0f, 1.0f}; f32x2 r; r.x = __builtin_amdgcn_rcpf(d.x); r.y = __builtin_amdgcn_rcpf(d.y); return r; }
__device__ __forceinline__ f32x4 sigmoid4(f32x4 x) { const f32x2 a = sigmoid2((f32x2){x[0], x[1]}), b = sigmoid2((f32x2){x[2], x[3]}); return (f32x4){a.x, a.y, b.x, b.y}; }
__device__ __forceinline__ f32x4 silu4(f32x4 x) { return x * sigmoid4(x); }

namespace pg8 {
constexpr int BM = 256, BK = 64, HALF = 128, HTB = HALF * BK * 2, STAGE_BYTES = 8 * HTB, NXCD = 8, WGM = 8;
__host__ __device__ __forceinline__ int lds_byte(int r, int c) { const int st = (r >> 4) * 2 + (c >> 5), rr = r & 15, cc = c & 31, ob = rr * 64 + cc * 2; return st * 1024 + (ob ^ (((ob >> 9) & 1) << 5)); }
__host__ __device__ __forceinline__ void stage_rc(int b, int& R, int& C) { const int st = b / 1024, sb = b % 1024, swz = sb ^ (((sb >> 9) & 1) << 5); R = (st >> 1) * 16 + swz / 64; C = (st & 1) * 32 + (swz % 64) / 2; }
__host__ __device__ __forceinline__ int perm32(int rho) { const int n = rho >> 4, i = rho & 15; return 8 * (i >> 2) + 4 * n + (i & 3); }

struct Unit { unsigned A, B; int pm, pn, x; };
struct Gemm { const char* base; int lda, ldb, K; };

__device__ __forceinline__ bool grid_tile(int L, int nM, int nN, int& pm, int& pn) {
    const int nwg = nM * nN; if (L >= nwg) return false;
    int wgid = L; { const int q = nwg / NXCD, r = nwg % NXCD, xcd = wgid % NXCD, off = wgid / NXCD; wgid = (xcd < r ? xcd * (q + 1) : r * (q + 1) + (xcd - r) * q) + off; }
    const int nig = WGM * nN, gid = wgid / nig, fm = gid * WGM, gsz = (nM - fm) < WGM ? (nM - fm) : WGM;
    pm = fm + ((wgid % nig) % gsz); pn = (wgid % nig) / gsz; return true;
}

template <bool FP8, class Epi, class Sched>
__device__ __forceinline__ void gemm_phase(LAS unsigned char* lds, const Gemm g, const Sched& S, const Epi& E, int tid_in) {
    int tid_ = tid_in; asm volatile("" : "+v"(tid_));
    const int tid = tid_, wid = __builtin_amdgcn_readfirstlane(tid >> 6), lane = tid & 63, wr = wid >> 2, wc = wid & 3, fr = lane & 15, fq = lane >> 4;
    const int K = g.K, nt = K / BK;
    unsigned voffA, voffB;
    { int R, C; stage_rc(tid * 16, R, C); const int Rb = (R & ~31) + perm32(R & 31); voffA = (unsigned)(R * g.lda + C) * 2u; voffB = (unsigned)(Rb * g.ldb + C) * 2u; }
    const unsigned piecevoffA = 64u * (unsigned)g.lda * 2u, piecevoffB = 64u * (unsigned)g.ldb * 2u;
    const unsigned kstep = (unsigned)(BK * 2);
    const unsigned hstepA = (unsigned)HALF * g.lda * 2u, hstepB = (unsigned)HALF * g.ldb * 2u;
    const char* const gb = g.base;
    const unsigned ldsw = (unsigned)wid * 1024u;
    const int aoff = lds_byte(wr * 64 + fr, fq * 8), boff = lds_byte(wc * 32 + fr, fq * 8);
#define PG8_SA(b, h) (((b) * 2 + (h)) * HTB)
#define PG8_SB(b, h) ((4 + (b) * 2 + (h)) * HTB)
#define PG8_STAGE2(bufoff, gbase, voff, piece) do { _Pragma("unroll") for (int _i = 0; _i < 2; ++_i) \
        __builtin_amdgcn_global_load_lds((const unsigned*)((gb + (size_t)(unsigned)((gbase) + _i * (piece))) + (size_t)(voff)), (LAS unsigned*)(lds + (bufoff) + ldsw + _i * 8192), 16, 0, 0); } while (0)
#define PG8_STAGE(bufoff, gbase, voff) PG8_STAGE2(bufoff, gbase, voff, piece##voff)
#define PG8_LDA(dst, b, h) do { _Pragma("unroll") for (int m = 0; m < 4; ++m) _Pragma("unroll") for (int k = 0; k < 2; ++k) dst[m][k] = *(const LAS bf16x8*)(lds + PG8_SA(b, h) + aoff + m * 2048 + k * 1024); } while (0)
#define PG8_LDB(dst, b, h) do { _Pragma("unroll") for (int n = 0; n < 2; ++n) _Pragma("unroll") for (int k = 0; k < 2; ++k) dst[n][k] = *(const LAS bf16x8*)(lds + PG8_SB(b, h) + boff + n * 2048 + k * 1024); } while (0)
#define PG8_CAT(lo, hi) __builtin_shufflevector(__builtin_bit_cast(i32x4, lo), __builtin_bit_cast(i32x4, hi), 0, 1, 2, 3, 4, 5, 6, 7)
#define PG8_MMA(ai, bj, At, Bt) do { __builtin_amdgcn_s_setprio(1); _Pragma("unroll") for (int m = 0; m < 4; ++m) _Pragma("unroll") for (int n = 0; n < 2; ++n) { \
        if constexpr (FP8) acc[ai][bj][m][n] = __builtin_amdgcn_mfma_scale_f32_16x16x128_f8f6f4(PG8_CAT(Bt[n][0], Bt[n][1]), PG8_CAT(At[m][0], At[m][1]), acc[ai][bj][m][n], 0, 0, 0, 0, 0, 0);     \
        else { _Pragma("unroll") for (int k = 0; k < 2; ++k) acc[ai][bj][m][n] = __builtin_amdgcn_mfma_f32_16x16x32_bf16(Bt[n][k], At[m][k], acc[ai][bj][m][n], 0, 0, 0); } } \
        __builtin_amdgcn_s_setprio(0); } while (0)
#define PG8_WAIT_V(n) asm volatile("s_waitcnt vmcnt(" #n ")" ::: "memory")
#define PG8_WAIT_L(n) asm volatile("s_waitcnt lgkmcnt(" #n ")" ::: "memory")
#define PG8_BAR __builtin_amdgcn_s_barrier()
#define PG8_SCHED __builtin_amdgcn_sched_barrier(0)
    Unit cur, nxt; int ui = 0;
    if (!S.next(0, cur)) return;
    f32x4 acc[2][2][4][2];
#pragma unroll
    for (int a = 0; a < 2; ++a)
#pragma unroll
        for (int b = 0; b < 2; ++b)
#pragma unroll
            for (int m = 0; m < 4; ++m)
#pragma unroll
                for (int n = 0; n < 2; ++n) acc[a][b][m][n] = (f32x4){0.f, 0.f, 0.f, 0.f};
    bf16x8 At[4][2], B0[2][2], B1[2][2];
    unsigned cA = cur.A, cB = cur.B;
    PG8_STAGE(PG8_SB(0, 0), cB, voffB); PG8_STAGE(PG8_SB(0, 1), cB + hstepB, voffB); PG8_STAGE(PG8_SA(0, 0), cA, voffA); PG8_STAGE(PG8_SA(0, 1), cA + hstepA, voffA);
    if (wr == 1) PG8_BAR;
    PG8_WAIT_V(2); PG8_BAR;
    PG8_STAGE(PG8_SB(1, 0), cB + kstep, voffB); PG8_STAGE(PG8_SA(1, 0), cA + kstep, voffA); PG8_STAGE(PG8_SB(1, 1), cB + hstepB + kstep, voffB);
    PG8_WAIT_V(6); PG8_BAR;
    for (;;) {
        const bool has_next = S.next(ui + 1, nxt);
        const unsigned nA = has_next ? nxt.A : cA, nB = has_next ? nxt.B : cB;
#pragma unroll 1
        for (int t = 0; t < nt; t += 2) {
            const bool last = (t == nt - 2);
            const unsigned a1 = cA + (unsigned)(t + 1) * kstep;
            const unsigned a2 = last ? nA : cA + (unsigned)(t + 2) * kstep, b2 = last ? nB : cB + (unsigned)(t + 2) * kstep;
            const unsigned a3 = a2 + kstep, b3 = b2 + kstep;
            const bool relax = (t == 0) && (ui > 0);
#define PG8_WAIT_FIRST() do { if (relax) { if constexpr (Epi::NST == 8) PG8_WAIT_V(16); else PG8_WAIT_V(24); } else PG8_WAIT_V(8); } while (0)
            PG8_LDB(B0, 0, 0); PG8_LDB(B1, 0, 1); PG8_SCHED; PG8_LDA(At, 0, 0); PG8_STAGE(PG8_SA(1, 1), a1 + hstepA, voffA);
            PG8_WAIT_FIRST(); PG8_WAIT_L(0); PG8_BAR; PG8_MMA(0, 0, At, B0); PG8_MMA(0, 1, At, B1); PG8_BAR; PG8_SCHED;
            PG8_LDA(At, 0, 1); PG8_STAGE(PG8_SB(0, 0), b2, voffB); PG8_STAGE(PG8_SB(0, 1), b2 + hstepB, voffB); PG8_STAGE(PG8_SA(0, 0), a2, voffA);
            PG8_WAIT_FIRST(); PG8_WAIT_L(0); PG8_BAR; PG8_MMA(1, 0, At, B0); PG8_MMA(1, 1, At, B1); PG8_BAR; PG8_SCHED;
            PG8_LDB(B0, 1, 0); PG8_LDB(B1, 1, 1); PG8_SCHED; PG8_LDA(At, 1, 0); PG8_STAGE(PG8_SA(0, 1), a2 + hstepA, voffA);
            PG8_WAIT_V(8); PG8_WAIT_L(0); PG8_BAR; PG8_MMA(0, 0, At, B0); PG8_MMA(0, 1, At, B1); PG8_BAR; PG8_SCHED;
            PG8_LDA(At, 1, 1); PG8_STAGE(PG8_SB(1, 0), b3, voffB); PG8_STAGE(PG8_SB(1, 1), b3 + hstepB, voffB); PG8_STAGE(PG8_SA(1, 0), a3, voffA);
            PG8_WAIT_V(8); PG8_WAIT_L(0); PG8_BAR; PG8_MMA(1, 0, At, B0); PG8_MMA(1, 1, At, B1); PG8_BAR; PG8_SCHED;
        }
        if (wr == 0) PG8_BAR;
        E(acc, cur, wr, wc, fr, fq);
        if (!has_next) break;
#pragma unroll
        for (int a = 0; a < 2; ++a)
#pragma unroll
            for (int b = 0; b < 2; ++b)
#pragma unroll
                for (int m = 0; m < 4; ++m)
#pragma unroll
                    for (int n = 0; n < 2; ++n) acc[a][b][m][n] = (f32x4){0.f, 0.f, 0.f, 0.f};
        cur = nxt; cA = nA; cB = nB; ++ui;
        if (wr == 1) PG8_BAR;
    }
    PG8_WAIT_V(0);
    PG8_BAR;
#undef PG8_SA
#undef PG8_SB
#undef PG8_STAGE
#undef PG8_STAGE2
#undef PG8_LDA
#undef PG8_LDB
#undef PG8_MMA
#undef PG8_WAIT_FIRST
#undef PG8_CAT
#undef PG8_WAIT_V
#undef PG8_WAIT_L
#undef PG8_BAR
#undef PG8_SCHED
}
}

constexpr size_t EPI_MiB = 1u << 20;
constexpr size_t EPI_WS_U = 111 * EPI_MiB, EPI_WS_Q = 143 * EPI_MiB, EPI_WS_LF = 175 * EPI_MiB, EPI_WS_V = 239 * EPI_MiB, EPI_WS_GG = 271 * EPI_MiB, EPI_WS_GT = 303 * EPI_MiB, EPI_WS_H = 47 * EPI_MiB, EPI_WS_LB = 1 * EPI_MiB;
typedef f32x4 AccT[2][2][4][2];
#define EPI_ROW0(u) ((u).pm * 256 + wr * 64 + fr)
__device__ __forceinline__ u32x4 pack8(const f32x4 a, const f32x4 b) { u32x4 w; w.x = cvt_pk_bf16(a[0], a[1]); w.y = cvt_pk_bf16(a[2], a[3]); w.z = cvt_pk_bf16(b[0], b[1]); w.w = cvt_pk_bf16(b[2], b[3]); return w; }

struct EpiIn {
    static constexpr int NST = 16;
    unsigned char* ws; const float* gbias; int layer;
    __device__ __forceinline__ void operator()(const AccT& acc, const pg8::Unit& u, int wr, int wc, int fr, int fq) const {
        unsigned char* wb = ws; asm volatile("" : "+s"(wb));
        GAS unsigned char* const wg = (GAS unsigned char*)wb;
        GAS bf16_t* const U = (GAS bf16_t*)(wg + EPI_WS_U); GAS bf16_t* const Q = (GAS bf16_t*)(wg + EPI_WS_Q); GAS bf16_t* const V = (GAS bf16_t*)(wg + EPI_WS_V); GAS bf16_t* const G = (GAS bf16_t*)(wg + EPI_WS_GG); GAS bf16_t* const GT = (GAS bf16_t*)(wg + EPI_WS_GT);
        GAS float* const LF = (GAS float*)(wg + EPI_WS_LF); const GAS float* const lb = (const GAS float*)(wg + EPI_WS_LB) + layer * HW;
        const int row0 = EPI_ROW0(u), cw = wc * 32 + 8 * fq;
        if (u.pn >= 10) {
            const int c0 = (u.pn - 10) * 256 + cw;
            f32x4 bb[2][2];
#pragma unroll
            for (int bj = 0; bj < 2; ++bj) { bb[bj][0] = *(const f32x4*)(gbias + c0 + bj * 128); bb[bj][1] = *(const f32x4*)(gbias + c0 + bj * 128 + 4); }
#pragma unroll
            for (int bj = 0; bj < 2; ++bj) { const int c = c0 + bj * 128; const f32x4 b0 = bb[bj][0], b1 = bb[bj][1];
#pragma unroll
                for (int ai = 0; ai < 2; ++ai)
#pragma unroll
                    for (int m = 0; m < 4; ++m) { f32x4 v0 = acc[ai][bj][m][0] + b0, v1 = acc[ai][bj][m][1] + b1;
#pragma unroll
                        for (int j = 0; j < 4; ++j) { v0[j] = sigmoidf_(v0[j]); v1[j] = sigmoidf_(v1[j]); }
                        *(GAS u32x4*)(GT + (size_t)(row0 + ai * 128 + m * 16) * NGATE + c) = pack8(v0, v1); } }
        } else if ((u.pn >> 1) == 2) {
            const int c0 = (u.pn - 4) * 256 + cw;
            f32x4 ll[2][2];
#pragma unroll
            for (int bj = 0; bj < 2; ++bj) { ll[bj][0] = *(const GAS f32x4*)(lb + c0 + bj * 128); ll[bj][1] = *(const GAS f32x4*)(lb + c0 + bj * 128 + 4); }
#pragma unroll
            for (int bj = 0; bj < 2; ++bj) { const int c = c0 + bj * 128; const f32x4 l0 = ll[bj][0], l1 = ll[bj][1];
#pragma unroll
                for (int ai = 0; ai < 2; ++ai)
#pragma unroll
                    for (int m = 0; m < 4; ++m) { f32x4 v0 = acc[ai][bj][m][0], v1 = acc[ai][bj][m][1];
                        { const f32x4 s0 = sigmoid4(v0), s1 = sigmoid4(v1); const f32x4 f0 = __builtin_elementwise_max(l0, (f32x4){1e-30f, 1e-30f, 1e-30f, 1e-30f}) + ((f32x4){1.f, 1.f, 1.f, 1.f} - l0) * s0, f1 = __builtin_elementwise_max(l1, (f32x4){1e-30f, 1e-30f, 1e-30f, 1e-30f}) + ((f32x4){1.f, 1.f, 1.f, 1.f} - l1) * s1;
#pragma unroll
                          for (int j = 0; j < 4; ++j) { v0[j] = __logf(f0[j]); v1[j] = __logf(f1[j]); } }
                        GAS float* o = LF + (size_t)(row0 + ai * 128 + m * 16) * HW + c; *(GAS f32x4*)o = v0; *(GAS f32x4*)(o + 4) = v1; } }
        } else {
            const int kind = u.pn >> 1; GAS bf16_t* dst = kind == 0 ? U : (kind == 1 ? Q : (kind == 3 ? V : G)); const bool act = (kind == 1) || (kind == 4);
            const int c0 = (u.pn & 1) * 256 + cw;
#pragma unroll
            for (int bj = 0; bj < 2; ++bj) { const int c = c0 + bj * 128;
#pragma unroll
                for (int ai = 0; ai < 2; ++ai)
#pragma unroll
                    for (int m = 0; m < 4; ++m) { f32x4 v0 = acc[ai][bj][m][0], v1 = acc[ai][bj][m][1];
                        if (act) { v0 = silu4(v0); v1 = silu4(v1); }
                        *(GAS u32x4*)(dst + (size_t)(row0 + ai * 128 + m * 16) * PW + c) = pack8(v0, v1); } }
        }
    }
};
struct EpiGate8 {
    static constexpr int NST = 16;
    unsigned char* ws; const float* gbias; float cs;
    __device__ __forceinline__ void operator()(const AccT& acc, const pg8::Unit& u, int wr, int wc, int fr, int fq) const {
        unsigned char* wb = ws; float csl = cs; asm volatile("" : "+s"(wb), "+s"(csl));
        GAS bf16_t* const GT = (GAS bf16_t*)((GAS unsigned char*)wb + EPI_WS_GT);
        const int row0 = EPI_ROW0(u), c0 = u.pn * 256 + wc * 32 + 8 * fq;
        f32x4 bb[2][2];
#pragma unroll
        for (int bj = 0; bj < 2; ++bj) { bb[bj][0] = *(const f32x4*)(gbias + c0 + bj * 128); bb[bj][1] = *(const f32x4*)(gbias + c0 + bj * 128 + 4); }
#pragma unroll
        for (int bj = 0; bj < 2; ++bj) { const int c = c0 + bj * 128;
#pragma unroll
            for (int ai = 0; ai < 2; ++ai)
#pragma unroll
                for (int m = 0; m < 4; ++m) { f32x4 v0 = acc[ai][bj][m][0] * csl + bb[bj][0], v1 = acc[ai][bj][m][1] * csl + bb[bj][1];
                    v0 = sigmoid4(v0); v1 = sigmoid4(v1);
                    *(GAS u32x4*)(GT + (size_t)(row0 + ai * 128 + m * 16) * NGATE + c) = pack8(v0, v1); } }
    }
};
struct EpiU {
    static constexpr int NST = 16;
    unsigned char* ws;
    __device__ __forceinline__ void operator()(const AccT& acc, const pg8::Unit& u, int wr, int wc, int fr, int fq) const {
        unsigned char* wb = ws; asm volatile("" : "+s"(wb));
        GAS unsigned char* const wg = (GAS unsigned char*)wb;
        GAS bf16_t* const MG = (GAS bf16_t*)(wg + EPI_WS_H); const GAS bf16_t* const GT = (const GAS bf16_t*)(wg + EPI_WS_GT);
        const int row0 = EPI_ROW0(u), c0 = u.pn * 256 + wc * 32 + 8 * fq;
#pragma unroll
        for (int ai = 0; ai < 2; ++ai) {
            u32x4 gw[4][2], tw[4][2];
#pragma unroll
            for (int m = 0; m < 4; ++m)
#pragma unroll
                for (int bj = 0; bj < 2; ++bj) { const size_t row = (size_t)(row0 + ai * 128 + m * 16); const int c = c0 + bj * 128;
                    gw[m][bj] = *(const GAS u32x4*)(GT + row * NGATE + u.x * 1024 + c);
                    tw[m][bj] = u.x ? *(const GAS u32x4*)(MG + row * D + c) : (u32x4){0u, 0u, 0u, 0u}; }
#pragma unroll
            for (int m = 0; m < 4; ++m)
#pragma unroll
                for (int bj = 0; bj < 2; ++bj) { const size_t row = (size_t)(row0 + ai * 128 + m * 16); const int c = c0 + bj * 128; const u32x4 g = gw[m][bj], t = tw[m][bj];
                    f32x4 v0 = acc[ai][bj][m][0], v1 = acc[ai][bj][m][1];
                    v0[0] = v0[0] * bf_lo(g.x) + bf_lo(t.x); v0[1] = v0[1] * bf_hi(g.x) + bf_hi(t.x); v0[2] = v0[2] * bf_lo(g.y) + bf_lo(t.y); v0[3] = v0[3] * bf_hi(g.y) + bf_hi(t.y);
                    v1[0] = v1[0] * bf_lo(g.z) + bf_lo(t.z); v1[1] = v1[1] * bf_hi(g.z) + bf_hi(t.z); v1[2] = v1[2] * bf_lo(g.w) + bf_lo(t.w); v1[3] = v1[3] * bf_hi(g.w) + bf_hi(t.w);
                    *(GAS u32x4*)(MG + row * D + c) = pack8(v0, v1); }
        }
    }
};
struct EpiRow {
    static constexpr int NST = 16;
    bf16_t* O; int ldo; const float* rowscale; float cs;
    __device__ __forceinline__ void operator()(const AccT& acc, const pg8::Unit& u, int wr, int wc, int fr, int fq) const {
        const int row0 = EPI_ROW0(u), c0 = u.pn * 256 + wc * 32 + 8 * fq; float csl = cs; asm volatile("" : "+s"(csl));
        float sc[2][4];
#pragma unroll
        for (int ai = 0; ai < 2; ++ai)
#pragma unroll
            for (int m = 0; m < 4; ++m) sc[ai][m] = rowscale ? rowscale[row0 + ai * 128 + m * 16] * csl : csl;
#pragma unroll
        for (int ai = 0; ai < 2; ++ai)
#pragma unroll
            for (int m = 0; m < 4; ++m) { const size_t row = (size_t)(row0 + ai * 128 + m * 16); const float s = sc[ai][m];
#pragma unroll
                for (int bj = 0; bj < 2; ++bj) *(u32x4*)(O + row * ldo + c0 + bj * 128) = pack8(acc[ai][bj][m][0] * s, acc[ai][bj][m][1] * s); }
    }
};
struct EpiSwi {
    static constexpr int NST = 8;
    bf16_t* ACT; int ldact;
    __device__ __forceinline__ void operator()(const AccT& acc, const pg8::Unit& u, int wr, int wc, int fr, int fq) const {
        const int row0 = u.x * 256 + wr * 64 + fr, c0 = u.pn * 128 + wc * 32 + 8 * fq;
#pragma unroll
        for (int ai = 0; ai < 2; ++ai)
#pragma unroll
            for (int m = 0; m < 4; ++m) { f32x4 v0 = acc[ai][0][m][0], v1 = acc[ai][0][m][1]; const f32x4 u0 = acc[ai][1][m][0], u1 = acc[ai][1][m][1];
                v0 = silu4(v0) * u0; v1 = silu4(v1) * u1;
                *(u32x4*)(ACT + (size_t)(row0 + ai * 128 + m * 16) * ldact + c0) = pack8(v0, v1); }
    }
};

struct EpiSwi8 {
    static constexpr int NST = 8;
    unsigned char* ACT; int ldact; float in_scale, out_scale;
    __device__ __forceinline__ void operator()(const AccT& acc, const pg8::Unit& u, int wr, int wc, int fr, int fq) const {
        const int row0 = u.x * 256 + wr * 64 + fr, c0 = u.pn * 128 + wc * 32 + 8 * fq; const float lim = f8_limit();
        float kE_ = -in_scale * 1.44269504088896f, kU_ = in_scale * in_scale * out_scale; asm volatile("" : "+s"(kE_), "+s"(kU_));
        const f32x2 kE = {kE_, kE_}, kU = {kU_, kU_}, one = {1.0f, 1.0f};
#pragma unroll
        for (int ai = 0; ai < 2; ++ai)
#pragma unroll
            for (int m = 0; m < 4; ++m) { unsigned w[2];
#pragma unroll
                for (int n = 0; n < 2; ++n) { const f32x4 g4 = acc[ai][0][m][n], u4 = acc[ai][1][m][n]; f32x2 o[2];
#pragma unroll
                    for (int h = 0; h < 2; ++h) { const f32x2 g = {g4[2 * h], g4[2 * h + 1]}, uu = {u4[2 * h], u4[2 * h + 1]};
                        const f32x2 t = g * kE; f32x2 e; e.x = __builtin_amdgcn_exp2f(t.x); e.y = __builtin_amdgcn_exp2f(t.y);
                        const f32x2 d = e + one; f32x2 r; r.x = __builtin_amdgcn_rcpf(d.x); r.y = __builtin_amdgcn_rcpf(d.y);
                        o[h] = (g * r) * (uu * kU); }
                    w[n] = pk4_fp8(o[0].x, o[0].y, o[1].x, o[1].y, lim); }
                u32x2 ww; ww.x = w[0]; ww.y = w[1];
                *(u32x2*)(ACT + (size_t)(row0 + ai * 128 + m * 16) * ldact + c0) = ww;
                __builtin_amdgcn_sched_barrier(0); }
    }
};

struct GridOrder {
    unsigned Abase, Bbase, atile, btile; int nM, nN, G, c;
    __device__ __forceinline__ bool next(int i, pg8::Unit& u) const {
        int pm, pn; if (!pg8::grid_tile(i * G + c, nM, nN, pm, pn)) return false;
        u.pm = pm; u.pn = pn; u.x = 0; u.A = Abase + (unsigned)pm * atile; u.B = Bbase + (unsigned)pn * btile; return true; }
};
struct UOrder {
    unsigned Abase, Bbase; int G, c;
    __device__ __forceinline__ bool next(int i, pg8::Unit& u) const {
        int pm, pn; if (!pg8::grid_tile((i >> 1) * G + c, M / 256, D / 256, pm, pn)) return false;
        u.pm = pm; u.pn = pn; u.x = i & 1; u.A = Abase + (unsigned)pm * (256u * 1024 * 2) + (unsigned)(i & 1) * 1024u; u.B = Bbase + (unsigned)pn * (256u * 1024 * 2) + (unsigned)(i & 1) * 1024u; return true; }
};
struct GuOrder {
    unsigned Abase, Bbase; const int* tile_expert; unsigned bexp, tileb; int t0, nT, nN, G, c;
    __device__ __forceinline__ bool next(int i, pg8::Unit& u) const {
        int pm, pn; if (!pg8::grid_tile(i * G + c, nT, nN, pm, pn)) return false;
        const int tile = t0 + pm; const int e = tile_expert ? __builtin_amdgcn_readfirstlane(__hip_atomic_load(tile_expert + tile, __ATOMIC_RELAXED, __HIP_MEMORY_SCOPE_AGENT)) : 0;
        u.pm = tile; u.pn = pn; u.x = pm; u.A = Abase + (unsigned)tile * tileb; u.B = Bbase + (unsigned)e * bexp + (unsigned)pn * tileb; return true; }
};
struct DownOrder {
    unsigned Abase, Bbase; const int* tile_expert; unsigned bexp, atile; int t0, nT, G, c;
    __device__ __forceinline__ bool next(int i, pg8::Unit& u) const {
        int pm, pn; if (!pg8::grid_tile(i * G + c, nT, D / 256, pm, pn)) return false;
        const int tile = t0 + pm; const int e = tile_expert ? __builtin_amdgcn_readfirstlane(__hip_atomic_load(tile_expert + tile, __ATOMIC_RELAXED, __HIP_MEMORY_SCOPE_AGENT)) : 0;
        u.pm = tile; u.pn = pn; u.x = pm; u.A = Abase + (unsigned)pm * atile; u.B = Bbase + (unsigned)e * bexp + (unsigned)pn * atile; return true; }
};

constexpr size_t MiB = 1u << 20;
constexpr size_t WS_CTL = 0, CTL_BYTES = 1 * MiB;
constexpr size_t WS_SMALL = 1 * MiB;
constexpr size_t SM_LB = 0, SM_CNTWG = 4096, SM_TOKE = 16384, SM_TOKW = 147456, SM_TOKS = 409600, SM_ROWIDX = 671744, SM_ROWSC = 999424, SM_TILEEXP = 1327104, SM_NT = 1328384, SM_DT = 1536 * 1024;
constexpr int MAXT = 272, NSLOT = MAXT * 256;
static_assert(SM_ROWIDX + (size_t)NSLOT * 4 <= SM_ROWSC && SM_ROWSC + (size_t)NSLOT * 4 <= SM_TILEEXP && SM_DT + 256 * 128 * 4 <= 3 * MiB, "small map");
constexpr size_t WS_WIN = 4 * MiB, WS_WU = 22 * MiB, WS_WOUT = 26 * MiB, WS_DGU = 30 * MiB, WS_DDN = 41 * MiB;
constexpr size_t WS_H = 47 * MiB;
constexpr size_t WS_U = 111 * MiB, WS_Q = 143 * MiB, WS_LF = 175 * MiB, WS_V = 239 * MiB, WS_GG = 271 * MiB, WS_GT = 303 * MiB, WS_A2 = 431 * MiB, WS_SL = 495 * MiB, WS_SI = 511 * MiB;
constexpr size_t WS_H8 = WS_SL;
constexpr size_t WS_WG8 = 528 * MiB;
constexpr size_t WS_MO = 111 * MiB;
constexpr size_t WS_ACT0 = 111 * MiB, WS_DN0 = 287 * MiB;
constexpr size_t WS_ACT1 = 111 * MiB, WS_H2G = 237 * MiB, WS_DN1 = 305 * MiB, WS_MW = 441 * MiB;
constexpr int MOE_G0 = 128, MOE_G1 = 144, MOE_NG = 2;
constexpr size_t MW_GU_E = (size_t)2 * DFF1 * D, MW_DN_E = (size_t)D * DFF1;
constexpr size_t WS_MWD = WS_MW + NEXP * MW_GU_E;
constexpr size_t WS_END = 548 * MiB;
constexpr float F8_W = 256.0f, F8_H = 16.0f, F8_A = 8.0f;
static_assert(WS_MWD + NEXP * MW_DN_E <= WS_END && WS_H2G + (size_t)NSLOT * D <= WS_DN1 && WS_DN1 + (size_t)NSLOT * D * 2 <= WS_MW && WS_ACT1 + (size_t)MOE_G1 * 256 * DFF1 <= WS_H2G && MOE_G0 + MOE_G1 >= MAXT && WS_SI + 16 * MiB <= WS_END, "ws map");
static_assert(EPI_WS_U == WS_U && EPI_WS_Q == WS_Q && EPI_WS_LF == WS_LF && EPI_WS_V == WS_V && EPI_WS_GG == WS_GG && EPI_WS_GT == WS_GT && EPI_WS_H == WS_H && EPI_WS_LB == WS_SMALL + SM_LB, "epilogue offsets");
static_assert(WS_ACT0 + (size_t)M * DFF0 * 2 <= WS_DN0 && WS_DDN + (size_t)D * DFF0 * 2 <= WS_H, "ws map 2");
constexpr int CW_BAR = 4096;

constexpr int RING_BYTES = 131072, MISC_OFF = RING_BYTES, LDS_BYTES = 147456;
constexpr int NW = 8, NT = 512;
#define LDS_WAIT() asm volatile("s_waitcnt lgkmcnt(0)" ::: "memory")
#define VM_WAIT() asm volatile("s_waitcnt vmcnt(0)" ::: "memory")

#define XB_TMO      128
#define XB_XCNT(j)  (256  + 64 * (j))
#define XB_XSUB(j)  (1280 + 64 * (j))
#define XB_XGEN(j)  (2304 + 64 * (j))
#define XB_TOP      3328
#define XB_TOPGEN   3392
#define XCD_BAR_WORDS 3456
#define XB_SPIN_CAP (1u << 18)
__device__ __forceinline__ unsigned xb_ld(unsigned* p)              { return __hip_atomic_load(p, __ATOMIC_RELAXED, __HIP_MEMORY_SCOPE_AGENT); }
__device__ __forceinline__ unsigned xb_add(unsigned* p, unsigned v) { return __hip_atomic_fetch_add(p, v, __ATOMIC_RELAXED, __HIP_MEMORY_SCOPE_AGENT); }
__device__ __forceinline__ unsigned xb_xcc_id() { return (unsigned)__builtin_amdgcn_s_getreg((3 << 11) | 20) & 0xFu; }
#define XB_SPIN(cond, bar) do { unsigned _sp = 0; while (cond) { __builtin_amdgcn_s_sleep(1); \
    if ((++_sp & 255u) == 0u) { if (xb_ld(&(bar)[XB_TMO])) break; if (_sp > XB_SPIN_CAP) { atomicAdd(&(bar)[XB_TMO], 1u); break; } } } } while (0)
struct XcdBarrier { unsigned* bar; unsigned x; volatile LAS unsigned* st; };
__device__ __forceinline__ XcdBarrier xcd_barrier_post(unsigned* bar, volatile LAS unsigned* st, int tid) {
    XcdBarrier b; b.bar = bar; b.x = xb_xcc_id(); b.st = st;
    if (tid == 0) (void)xb_add(&bar[XB_XCNT(b.x)], 1u);
    return b;
}
__device__ __forceinline__ void xcd_barrier_complete(unsigned* bar, unsigned x, unsigned& nloc, unsigned& nx) {
    const unsigned G = gridDim.x * gridDim.y * gridDim.z;
    unsigned sum, cnt, mine, sp = 0u;
    for (;;) {
        sum = 0u; cnt = 0u; mine = 0u;
#pragma unroll
        for (unsigned j = 0; j < 16; ++j) { const unsigned c = xb_ld(&bar[XB_XCNT(j)]); sum += c; cnt += (c > 0u) ? 1u : 0u; mine = (j == x) ? c : mine; }
        if (sum == G) break;
        __builtin_amdgcn_s_sleep(1);
        if ((++sp & 255u) == 0u) { if (xb_ld(&bar[XB_TMO])) break; if (sp > XB_SPIN_CAP) { atomicAdd(&bar[XB_TMO], 1u); break; } }
    }
    nloc = mine > 0u ? mine : 1u; nx = cnt > 0u ? cnt : 1u;
}
__device__ __forceinline__ void xcd_barrier(const XcdBarrier& b, int tid) {
    asm volatile("s_waitcnt vmcnt(0)" ::: "memory");
    __syncthreads();
    if (tid == 0) {
        unsigned* bar = b.bar;
        __builtin_amdgcn_s_waitcnt(0);
        unsigned nloc = b.st[0], nx = b.st[1];
        if (nloc == 0u) { xcd_barrier_complete(bar, b.x, nloc, nx); b.st[0] = nloc; b.st[1] = nx; }
        const unsigned old = xb_add(&bar[XB_XSUB(b.x)], 1u);
        const unsigned gen = old / nloc;
        if (old + 1u == (gen + 1u) * nloc) {
            __builtin_amdgcn_fence(__ATOMIC_RELEASE, "agent");
            asm volatile("s_waitcnt vmcnt(0)" ::: "memory");
            const unsigned og = xb_add(&bar[XB_TOP], 1u);
            const unsigned tg = og / nx;
            if (og + 1u == (tg + 1u) * nx) xb_add(&bar[XB_TOPGEN], 1u);
            else XB_SPIN(xb_ld(&bar[XB_TOPGEN]) == tg, bar);
            __builtin_amdgcn_fence(__ATOMIC_ACQUIRE, "agent");
            xb_add(&bar[XB_XGEN(b.x)], 1u);
            asm volatile("s_waitcnt vmcnt(0)" ::: "memory");
        } else {
            XB_SPIN(xb_ld(&bar[XB_XGEN(b.x)]) == gen, bar);
            __builtin_amdgcn_fence(__ATOMIC_ACQUIRE, "agent");
            asm volatile("s_waitcnt vmcnt(0)" ::: "memory");
        }
    }
    __syncthreads();
}

__device__ __forceinline__ float shfl_xor_l(float v, int o, int lane) { return __builtin_bit_cast(float, __builtin_amdgcn_ds_bpermute((lane ^ o) << 2, __builtin_bit_cast(int, v))); }
__device__ __forceinline__ float wave_sum(float v, int lane) {
#pragma unroll
    for (int o = 1; o < 64; o <<= 1) v += shfl_xor_l(v, o, lane);
    return v;
}
__device__ __forceinline__ void tr_item(const float* W, int N, int k0, int n0, bf16_t* dst, int ldd, LAS float* scr, int lane) {
    float v[32];
#pragma unroll
    for (int i = 0; i < 32; ++i) v[i] = W[(size_t)(k0 + 2 * i + (lane >> 5)) * N + n0 + (lane & 31)];
#pragma unroll
    for (int i = 0; i < 32; ++i) scr[(2 * i + (lane >> 5)) * 33 + (lane & 31)] = v[i];
    LDS_WAIT();
    const int c = lane & 7;
#pragma unroll
    for (int j = 0; j < 4; ++j) { const int n = (lane >> 3) + 8 * j; const LAS float* s = scr + (8 * c) * 33 + n;
        u32x4 o; o.x = cvt_pk_bf16(s[0 * 33], s[1 * 33]); o.y = cvt_pk_bf16(s[2 * 33], s[3 * 33]); o.z = cvt_pk_bf16(s[4 * 33], s[5 * 33]); o.w = cvt_pk_bf16(s[6 * 33], s[7 * 33]);
        *(u32x4*)(dst + (size_t)n * ldd + 8 * c) = o; }
    LDS_WAIT();
}
__device__ __forceinline__ void tr_item8(const float* W, int N, int k0, int n0, unsigned char* dst, int ldd, float scale, LAS float* scr, int lane) {
    float v[32];
#pragma unroll
    for (int i = 0; i < 32; ++i) v[i] = W[(size_t)(k0 + 2 * i + (lane >> 5)) * N + n0 + (lane & 31)];
#pragma unroll
    for (int i = 0; i < 32; ++i) scr[(2 * i + (lane >> 5)) * 33 + (lane & 31)] = v[i] * scale;
    LDS_WAIT();
    const int c = lane & 7; const float lim = f8_limit();
#pragma unroll
    for (int j = 0; j < 4; ++j) { const int n = (lane >> 3) + 8 * j; const LAS float* s = scr + (8 * c) * 33 + n;
        u32x2 o; o.x = pk4_fp8(s[0 * 33], s[1 * 33], s[2 * 33], s[3 * 33], lim); o.y = pk4_fp8(s[4 * 33], s[5 * 33], s[6 * 33], s[7 * 33], lim);
        *(u32x2*)(dst + (size_t)n * ldd + 8 * c) = o; }
    LDS_WAIT();
}
__device__ __forceinline__ void tr_plain(const float* W, int K, int N, bf16_t* WT, int ldd, int kcol0, int it, LAS float* scr, int lane) {
    const int nblk = N / 32, kb = it / nblk, nb = it % nblk;
    tr_item(W, N, 64 * kb, 32 * nb, WT + (size_t)(32 * nb) * ldd + kcol0 + 64 * kb, ldd, scr, lane);
}
__device__ __forceinline__ void tr_gu(const float* W, int dff, int isup, bf16_t* WT, int it, LAS float* scr, int lane) {
    const int nblk = dff / 32, kb = it / nblk, nb = it % nblk, n0 = 32 * nb, drow = 256 * (n0 >> 7) + 128 * isup + (n0 & 127);
    tr_item(W, dff, 64 * kb, n0, WT + (size_t)drow * D + 64 * kb, D, scr, lane);
}

struct Args { const float* in[20]; float* out; unsigned char* ws; int lo, hi; };
#define CAS __attribute__((address_space(4)))
struct Ctx {
    LAS unsigned char* lds; int tid, lane, wave, G, bid;
    const CAS Args* a;
};
#define CIN(i) (C.a->in[i])
#define C_WS (C.a->ws)
#define C_OUT (C.a->out)
#define C_G (C.G)
#define C_BID (C.bid)
#define WSP(T, off) ((T*)(C_WS + (off)))
#define SMP(T, off) ((T*)(C_WS + WS_SMALL + (off)))

__device__ __forceinline__ void phase_prologue(Ctx& C) {
    LAS float* scr = (LAS float*)(C.lds + C.wave * 16384);
    const int gw = C_BID * NW + C.wave, NGW = C_G * NW;
    constexpr int I_IN = (D / 64) * ((INC - NGATE) / 32), I_HU = (HW / 64) * (D / 32), I_WO = (D / 64) * (D / 32), I_GU = (D / 64) * (DFF0 / 32), I_DN = (DFF0 / 64) * (D / 32);
    constexpr int I_G8 = (D / 64) * (NGATE / 32);
    constexpr int NITEMS = 2 * (I_IN + I_HU + I_WO) + 2 * I_GU + I_DN + 2 * I_G8;
    for (int it = gw; it < NITEMS; it += NGW) {
        int r = it;
        if (r < 2 * I_IN) { const int l = r / I_IN, q = r % I_IN, nblk = (INC - NGATE) / 32, kb = q / nblk, nb = q % nblk;
            tr_item(CIN(2) + (size_t)l * D * INC, INC, 64 * kb, 32 * nb, WSP(bf16_t, WS_WIN) + (size_t)l * INC * D + (size_t)(32 * nb) * D + 64 * kb, D, scr, C.lane); continue; } r -= 2 * I_IN;
        if (r < 2 * I_HU) { const int l = r / I_HU; tr_plain(CIN(9) + (size_t)l * HW * D, HW, D, WSP(bf16_t, WS_WU) + (size_t)l * D * D, D, 512, r % I_HU, scr, C.lane); continue; } r -= 2 * I_HU;
        if (r < 2 * I_WO) { const int l = r / I_WO; tr_plain(CIN(10) + (size_t)l * D * D, D, D, WSP(bf16_t, WS_WOUT) + (size_t)l * D * D, D, 0, r % I_WO, scr, C.lane); continue; } r -= 2 * I_WO;
        if (r < I_GU) { tr_gu(CIN(12), DFF0, 0, WSP(bf16_t, WS_DGU), r, scr, C.lane); continue; } r -= I_GU;
        if (r < I_GU) { tr_gu(CIN(13), DFF0, 1, WSP(bf16_t, WS_DGU), r, scr, C.lane); continue; } r -= I_GU;
        if (r < I_DN) { tr_plain(CIN(14), DFF0, D, WSP(bf16_t, WS_DDN), DFF0, 0, r, scr, C.lane); continue; } r -= I_DN;
        { const int l = r / I_G8, q = r % I_G8, nblk = NGATE / 32, kb = q / nblk, nb = q % nblk;
          tr_item8(CIN(2) + (size_t)l * D * INC, INC, 64 * kb, (INC - NGATE) + 32 * nb, C_WS + WS_WG8 + (size_t)l * NGATE * D + (size_t)(32 * nb) * D + 64 * kb, D, F8_W, scr, C.lane); }
    }
    for (int it = gw; it < 2 * 4 * 16 * 16; it += NGW) {
        const int nb = it & 15, kb = (it >> 4) & 15, g = (it >> 8) & 3, l = it >> 10;
        const float* pw = CIN(4) + ((size_t)l * PW + g * 128 + kb * 8) * 128; const float* ps = CIN(5) + l * PW + g * 128; const float* pu = CIN(6) + ((size_t)l * PW + g * 128) * D + nb * 64 + C.lane;
        float acc8[8];
#pragma unroll
        for (int j = 0; j < 8; ++j) acc8[j] = 0.f;
#pragma unroll 8
        for (int d = 0; d < 128; ++d) { const float x = ps[d] * pu[(size_t)d * D];
#pragma unroll
            for (int j = 0; j < 8; ++j) acc8[j] += pw[j * 128 + d] * x; }
        u32x4 o; o.x = cvt_pk_bf16(acc8[0], acc8[1]); o.y = cvt_pk_bf16(acc8[2], acc8[3]); o.z = cvt_pk_bf16(acc8[4], acc8[5]); o.w = cvt_pk_bf16(acc8[6], acc8[7]);
        *(u32x4*)(WSP(bf16_t, WS_WU) + (size_t)l * D * D + (size_t)(nb * 64 + C.lane) * D + g * 128 + kb * 8) = o;
    }
    if (C_BID == 0) { float* lbv = SMP(float, SM_LB);
        for (int c = C.tid; c < HW; c += NT) { const float b0 = CIN(7)[c], b1 = CIN(7)[HW + c], mx = fmaxf(b0, b1), e0 = expf(b0 - mx), e1 = expf(b1 - mx), s0 = e0 / (e0 + e1), s1 = e1 / (e0 + e1);
            lbv[c] = 0.f; lbv[HW + c] = fminf(fmaxf((s0 + s1) - s0, 0.f), 1.0f - 1e-6f); } }
}
__device__ __forceinline__ void phase_moe_weights(Ctx& C) {
    LAS float* scr = (LAS float*)(C.lds + C.wave * 16384);
    const int gw = C_BID * NW + C.wave, NGW = C_G * NW;
    constexpr int I_GU = (D / 64) * (DFF1 / 32), I_DN = (DFF1 / 64) * (D / 32);
    for (int it = gw; it < NEXP * (2 * I_GU + I_DN); it += NGW) {
        const int e = it / (2 * I_GU + I_DN); int r = it % (2 * I_GU + I_DN);
        if (r < 2 * I_GU) { const int isup = r >= I_GU ? 1 : 0; r -= isup * I_GU; const int nblk = DFF1 / 32, kb = r / nblk, nb = r % nblk, n0 = 32 * nb, drow = 256 * (n0 >> 7) + 128 * isup + (n0 & 127);
            tr_item8(CIN(16 + isup) + (size_t)e * D * DFF1, DFF1, 64 * kb, n0, C_WS + WS_MW + e * MW_GU_E + (size_t)drow * D + 64 * kb, D, F8_W, scr, C.lane); continue; }
        r -= 2 * I_GU;
        { const int nblk = D / 32, kb = r / nblk, nb = r % nblk;
          tr_item8(CIN(18) + (size_t)e * DFF1 * D, D, 64 * kb, 32 * nb, C_WS + WS_MWD + e * MW_DN_E + (size_t)(32 * nb) * DFF1 + 64 * kb, DFF1, F8_W, scr, C.lane); }
    }
}

__device__ __forceinline__ void phase_norm(Ctx& C, const float* xsrc, float* xdst, const float* w, bf16_t* hout, float* fout,
                                           const bf16_t* add, const int* slots, int nadd, const float* router, unsigned char* h8out = nullptr) {
    LAS float* RL = (LAS float*)C.lds;
    LAS int* cnt8 = (LAS int*)(C.lds + 32768);
    if (router) { for (int i = C.tid; i < D * NEXP / 4; i += NT) { const int c = i >> 1; ((LAS f32x4*)RL)[(i & 1) * 1024 + (4 * (c >> 8) + (c & 3)) * 64 + ((c & 255) >> 2)] = ((const f32x4*)router)[i]; } if (C.tid < 8) cnt8[C.tid] = 0; __syncthreads(); }
    float eps_ = EPS; asm volatile("" : "+s"(eps_));
    f32x4 wv[4];
#pragma unroll
    for (int j = 0; j < 4; ++j) wv[j] = ((const f32x4*)w)[64 * j + C.lane];
    for (int i = 0; i < 16; ++i) {
        const int row = C_BID * 128 + C.wave * 16 + i;
        const f32x4* xr = (const f32x4*)(xsrc + (size_t)row * D) + C.lane;
        f32x4 v[4];
#pragma unroll
        for (int j = 0; j < 4; ++j) v[j] = xr[64 * j];
        for (int a = 0; a < nadd; ++a) { const int ar = slots ? slots[2 * row + a] : row; const u32x2* p = (const u32x2*)(add + (size_t)ar * D) + C.lane;
#pragma unroll
            for (int j = 0; j < 4; ++j) { const u32x2 t = p[64 * j]; v[j][0] += bf_lo(t.x); v[j][1] += bf_hi(t.x); v[j][2] += bf_lo(t.y); v[j][3] += bf_hi(t.y); } }
        float ss = 0.f;
#pragma unroll
        for (int j = 0; j < 4; ++j) ss += (v[j][0] * v[j][0] + v[j][1] * v[j][1]) + (v[j][2] * v[j][2] + v[j][3] * v[j][3]);
        const float rs = 1.0f / sqrtf(wave_sum(ss, C.lane) * (1.0f / D) + eps_);
        if (xdst) { f32x4* xo = (f32x4*)(xdst + (size_t)row * D) + C.lane;
#pragma unroll
            for (int j = 0; j < 4; ++j) xo[64 * j] = v[j]; }
#pragma unroll
        for (int j = 0; j < 4; ++j) v[j] = v[j] * rs * wv[j];
        if (hout) { u32x2* ho = (u32x2*)(hout + (size_t)row * D) + C.lane;
#pragma unroll
            for (int j = 0; j < 4; ++j) { u32x2 t; t.x = cvt_pk_bf16(v[j][0], v[j][1]); t.y = cvt_pk_bf16(v[j][2], v[j][3]); ho[64 * j] = t; } }
        if (h8out) { const float lim = f8_limit(); unsigned* h8 = (unsigned*)(h8out + (size_t)row * D) + C.lane;
#pragma unroll
            for (int j = 0; j < 4; ++j) h8[64 * j] = pk4_fp8(v[j][0] * F8_H, v[j][1] * F8_H, v[j][2] * F8_H, v[j][3] * F8_H, lim); }
        if (fout) { f32x4* fo = (f32x4*)(fout + (size_t)row * D) + C.lane;
#pragma unroll
            for (int j = 0; j < 4; ++j) fo[64 * j] = v[j]; }
        if (router) {
            float lg[8];
#pragma unroll
            for (int e = 0; e < 8; ++e) lg[e] = 0.f;
#pragma unroll
            for (int j = 0; j < 4; ++j)
#pragma unroll
                for (int q = 0; q < 4; ++q) { const LAS f32x4* rp = (const LAS f32x4*)RL + (4 * j + q) * 64 + C.lane; const f32x4 r0 = rp[0], r1 = rp[1024]; const float hv = v[j][q];
                    lg[0] += hv * r0[0]; lg[1] += hv * r0[1]; lg[2] += hv * r0[2]; lg[3] += hv * r0[3]; lg[4] += hv * r1[0]; lg[5] += hv * r1[1]; lg[6] += hv * r1[2]; lg[7] += hv * r1[3]; }
#pragma unroll
            for (int e = 0; e < 8; ++e) lg[e] = wave_sum(lg[e], C.lane);
            int e1 = 0; float v1 = lg[0];
#pragma unroll
            for (int e = 1; e < 8; ++e) if (lg[e] > v1) { v1 = lg[e]; e1 = e; }
            int e2 = -1; float v2 = -3.0e38f;
#pragma unroll
            for (int e = 0; e < 8; ++e) if (e != e1 && lg[e] > v2) { v2 = lg[e]; e2 = e; }
            const float ex = expf(v2 - v1), w1 = 1.0f / (1.0f + ex), w2 = ex / (1.0f + ex);
            if (C.lane == 0) { SMP(int, SM_TOKE)[row] = e1 | (e2 << 8); SMP(f32x2, SM_TOKW)[row] = (f32x2){w1, w2}; atomicAdd((int*)cnt8 + e1, 1); atomicAdd((int*)cnt8 + e2, 1); }
        }
    }
    if (router) { __syncthreads(); if (C.tid < 8) SMP(int, SM_CNTWG)[C_BID * 8 + C.tid] = cnt8[C.tid]; }
}

constexpr int TAILSLOT = 256 * 256;
__device__ __forceinline__ void phase_norm_router(Ctx& C, float* x, const float* w, const bf16_t* add, unsigned char* h8out, const float* router) {
    LAS float* RL = (LAS float*)C.lds;
    LAS int* cnt8 = (LAS int*)(C.lds + 32768);
    for (int i = C.tid; i < D * NEXP / 4; i += NT) { const int c = i >> 1; ((LAS f32x4*)RL)[(i & 1) * 1024 + (4 * (c >> 8) + (c & 3)) * 64 + ((c & 255) >> 2)] = ((const f32x4*)router)[i]; }
    if (C.tid < 8) cnt8[C.tid] = 0;
    __syncthreads();
    float eps_ = EPS; asm volatile("" : "+s"(eps_));
    f32x4 wv[4];
#pragma unroll
    for (int j = 0; j < 4; ++j) wv[j] = ((const f32x4*)w)[64 * j + C.lane];
    const int row0 = C_BID * 128 + C.wave * 16;
    const bool b0 = C.lane & 1, b1 = C.lane & 2, b2 = C.lane & 4;
    f32x4 xv[4]; u32x2 av[4];
    { const f32x4* xr = (const f32x4*)(x + (size_t)row0 * D) + C.lane; const u32x2* p = (const u32x2*)(add + (size_t)row0 * D) + C.lane;
#pragma unroll
      for (int j = 0; j < 4; ++j) { xv[j] = xr[64 * j]; av[j] = p[64 * j]; } }
    for (int i = 0; i < 16; ++i) {
        const int row = row0 + i;
        f32x4 v[4];
#pragma unroll
        for (int j = 0; j < 4; ++j) { v[j] = xv[j]; v[j][0] += bf_lo(av[j].x); v[j][1] += bf_hi(av[j].x); v[j][2] += bf_lo(av[j].y); v[j][3] += bf_hi(av[j].y); }
        { const int nrow = row0 + min(i + 1, 15); const f32x4* xr = (const f32x4*)(x + (size_t)nrow * D) + C.lane; const u32x2* p = (const u32x2*)(add + (size_t)nrow * D) + C.lane;
#pragma unroll
          for (int j = 0; j < 4; ++j) { xv[j] = xr[64 * j]; av[j] = p[64 * j]; } }
        float ss = 0.f;
#pragma unroll
        for (int j = 0; j < 4; ++j) ss += (v[j][0] * v[j][0] + v[j][1] * v[j][1]) + (v[j][2] * v[j][2] + v[j][3] * v[j][3]);
        const float rs = 1.0f / sqrtf(wave_sum(ss, C.lane) * (1.0f / D) + eps_);
        { f32x4* xo = (f32x4*)(x + (size_t)row * D) + C.lane;
#pragma unroll
          for (int j = 0; j < 4; ++j) xo[64 * j] = v[j]; }
#pragma unroll
        for (int j = 0; j < 4; ++j) v[j] = v[j] * rs * wv[j];
        { const float lim = f8_limit(); unsigned* h8 = (unsigned*)(h8out + (size_t)row * D) + C.lane;
#pragma unroll
          for (int j = 0; j < 4; ++j) h8[64 * j] = pk4_fp8(v[j][0] * F8_H, v[j][1] * F8_H, v[j][2] * F8_H, v[j][3] * F8_H, lim); }
        f32x2 lg[4];
#pragma unroll
        for (int e = 0; e < 4; ++e) lg[e] = (f32x2){0.f, 0.f};
#pragma unroll
        for (int j = 0; j < 4; ++j)
#pragma unroll
            for (int q = 0; q < 4; ++q) { const LAS f32x4* rp = (const LAS f32x4*)RL + (4 * j + q) * 64 + C.lane; const f32x4 r0 = rp[0], r1 = rp[1024]; const f32x2 hv = (f32x2){v[j][q], v[j][q]};
                lg[0] = __builtin_elementwise_fma(hv, (f32x2){r0[0], r0[1]}, lg[0]); lg[1] = __builtin_elementwise_fma(hv, (f32x2){r0[2], r0[3]}, lg[1]);
                lg[2] = __builtin_elementwise_fma(hv, (f32x2){r1[0], r1[1]}, lg[2]); lg[3] = __builtin_elementwise_fma(hv, (f32x2){r1[2], r1[3]}, lg[3]); }
        float t4[4], t2[2], t1;
        { const float a[8] = {lg[0][0], lg[0][1], lg[1][0], lg[1][1], lg[2][0], lg[2][1], lg[3][0], lg[3][1]};
#pragma unroll
          for (int k = 0; k < 4; ++k) { const float send = b0 ? a[k] : a[k + 4], keep = b0 ? a[k + 4] : a[k]; t4[k] = keep + shfl_xor_l(send, 1, C.lane); } }
#pragma unroll
        for (int k = 0; k < 2; ++k) { const float send = b1 ? t4[k] : t4[k + 2], keep = b1 ? t4[k + 2] : t4[k]; t2[k] = keep + shfl_xor_l(send, 2, C.lane); }
        { const float send = b2 ? t2[0] : t2[1], keep = b2 ? t2[1] : t2[0]; t1 = keep + shfl_xor_l(send, 4, C.lane); }
        t1 += shfl_xor_l(t1, 8, C.lane); t1 += shfl_xor_l(t1, 16, C.lane); t1 += shfl_xor_l(t1, 32, C.lane);
        float lt[8];
#pragma unroll
        for (int e = 0; e < 8; ++e) lt[e] = __builtin_bit_cast(float, __builtin_amdgcn_readlane(__builtin_bit_cast(int, t1), ((e >> 2) & 1) | (((e >> 1) & 1) << 1) | ((e & 1) << 2)));
        int e1 = 0; float v1 = lt[0];
#pragma unroll
        for (int e = 1; e < 8; ++e) if (lt[e] > v1) { v1 = lt[e]; e1 = e; }
        int e2 = -1; float v2 = -3.0e38f;
#pragma unroll
        for (int e = 0; e < 8; ++e) if (e != e1 && lt[e] > v2) { v2 = lt[e]; e2 = e; }
        const float ex = expf(v2 - v1), w1 = 1.0f / (1.0f + ex), w2 = ex / (1.0f + ex);
        if (C.lane == 0) { SMP(int, SM_TOKE)[row] = e1 | (e2 << 8); SMP(f32x2, SM_TOKW)[row] = (f32x2){w1, w2}; atomicAdd((int*)cnt8 + e1, 1); atomicAdd((int*)cnt8 + e2, 1); }
    }
    __syncthreads();
    if (C.tid < 8) SMP(int, SM_CNTWG)[C_BID * 8 + C.tid] = cnt8[C.tid];
}
__device__ __forceinline__ void phase_final(Ctx& C, int mode, int nskip) {
    const int vb = C_BID - nskip, nwk = C_G - nskip; if (vb < 0) return;
    const float* w = CIN(19); float* xo = C_OUT; const bf16_t* dn = WSP(bf16_t, WS_DN1); const int* slots = SMP(int, SM_TOKS);
    float eps_ = EPS; asm volatile("" : "+s"(eps_));
    f32x4 wv[4];
#pragma unroll
    for (int j = 0; j < 4; ++j) wv[j] = ((const f32x4*)w)[64 * j + C.lane];
    for (int row = vb * NW + C.wave; row < M; row += nwk * NW) {
        const int s1 = slots[2 * row], s2 = slots[2 * row + 1];
        const bool tail = (s1 >= TAILSLOT) || (s2 >= TAILSLOT);
        if ((mode == 1) == tail) continue;
        f32x4* xr = (f32x4*)(xo + (size_t)row * D) + C.lane; const u32x2* p1 = (const u32x2*)(dn + (size_t)s1 * D) + C.lane; const u32x2* p2_ = (const u32x2*)(dn + (size_t)s2 * D) + C.lane;
        f32x4 v[4]; u32x2 a[4], b[4];
#pragma unroll
        for (int j = 0; j < 4; ++j) { v[j] = xr[64 * j]; a[j] = p1[64 * j]; b[j] = p2_[64 * j]; }
        float ss = 0.f;
#pragma unroll
        for (int j = 0; j < 4; ++j) { v[j][0] += bf_lo(a[j].x) + bf_lo(b[j].x); v[j][1] += bf_hi(a[j].x) + bf_hi(b[j].x); v[j][2] += bf_lo(a[j].y) + bf_lo(b[j].y); v[j][3] += bf_hi(a[j].y) + bf_hi(b[j].y);
            ss += (v[j][0] * v[j][0] + v[j][1] * v[j][1]) + (v[j][2] * v[j][2] + v[j][3] * v[j][3]); }
        const float rs = 1.0f / sqrtf(wave_sum(ss, C.lane) * (1.0f / D) + eps_);
#pragma unroll
        for (int j = 0; j < 4; ++j) xr[64 * j] = v[j] * rs * wv[j];
    }
}
__device__ __forceinline__ void phase_route(Ctx& C) {
    LAS int* tot = (LAS int*)C.lds; LAS int* bef = tot + 8; LAS int* base = tot + 16;
    const int* cw = SMP(int, SM_CNTWG);
    { LAS int* pt = tot + 32; LAS int* pb = pt + 512; const int e = C.tid & 7, part = C.tid >> 3; int t = 0, b = 0;
#pragma unroll
      for (int q = 0; q < 4; ++q) { const int g = part * 4 + q; const int c = (g < C_G) ? cw[g * 8 + e] : 0; t += c; b += (g < C_BID) ? c : 0; }
      pt[C.tid] = t; pb[C.tid] = b; }
    __syncthreads();
    if (C.tid < 8) { LAS int* pt = tot + 32; LAS int* pb = pt + 512; int t = 0, b = 0;
#pragma unroll 8
        for (int p = 0; p < 64; ++p) { t += pt[p * 8 + C.tid]; b += pb[p * 8 + C.tid]; }
        tot[C.tid] = t; bef[C.tid] = b; }
    __syncthreads();
    if (C.tid == 0) { int s = 0; for (int e = 0; e < 8; ++e) { base[e] = s; s += ((tot[e] + 255) >> 8) << 8; } base[8] = s; }
    __syncthreads();
    int* rowidx = SMP(int, SM_ROWIDX); float* rowsc = SMP(float, SM_ROWSC);
    if (C_BID == 0) { const int ntiles = base[8] >> 8;
        for (int t = C.tid; t < MAXT; t += NT) { int e = 0; for (int q = 1; q < 8; ++q) e += (base[q] <= t * 256) ? 1 : 0; SMP(int, SM_TILEEXP)[t] = (t < ntiles) ? e : 0; }
        if (C.tid == 0) SMP(int, SM_NT)[0] = ntiles; }
    if (C_BID < 8) { const int e = C_BID; for (int s = base[e] + tot[e] + C.tid; s < base[e + 1]; s += NT) { rowidx[s] = 0; rowsc[s] = 0.f; } }
    if (C.wave == 0) {
        int run[8];
#pragma unroll
        for (int e = 0; e < 8; ++e) run[e] = base[e] + bef[e];
        for (int p = 0; p < 2; ++p) {
            const int tok = C_BID * 128 + p * 64 + C.lane; const int ee = SMP(int, SM_TOKE)[tok], e1 = ee & 255, e2 = ee >> 8; const f32x2 tw = SMP(f32x2, SM_TOKW)[tok];
            int s1 = 0, s2 = 0; const unsigned long long below = (1ull << C.lane) - 1ull;
#pragma unroll
            for (int e = 0; e < 8; ++e) { const bool has = (e1 == e) || (e2 == e); const unsigned long long m = __ballot(has); const int pos = run[e] + __popcll(m & below);
                if (e1 == e) s1 = pos; if (e2 == e) s2 = pos; run[e] += __popcll(m); }
            rowidx[s1] = tok; rowsc[s1] = tw.x; rowidx[s2] = tok; rowsc[s2] = tw.y; SMP(int, SM_TOKS)[2 * tok] = s1; SMP(int, SM_TOKS)[2 * tok + 1] = s2;
        }
    }
}
__device__ __forceinline__ void phase_gather(Ctx& C) {
    const int nslots = __hip_atomic_load(SMP(int, SM_NT), __ATOMIC_RELAXED, __HIP_MEMORY_SCOPE_AGENT) * 256; const int* rowidx = SMP(int, SM_ROWIDX);
    for (int s = C_BID * NW + C.wave; s < nslots; s += C_G * NW * 2) {
        const int s2 = s + C_G * NW; const bool has2 = s2 < nslots;
        const u32x4 a = *((const u32x4*)(C_WS + WS_H + (size_t)rowidx[s] * D) + C.lane);
        u32x4 b = a; if (has2) b = *((const u32x4*)(C_WS + WS_H + (size_t)rowidx[s2] * D) + C.lane);
        *((u32x4*)(C_WS + WS_H2G + (size_t)s * D) + C.lane) = a;
        if (has2) *((u32x4*)(C_WS + WS_H2G + (size_t)s2 * D) + C.lane) = b; }
}
__device__ __forceinline__ void phase_pool(Ctx& C) {
    const bf16_t* U = WSP(bf16_t, WS_U); bf16_t* A2 = WSP(bf16_t, WS_A2);
    const int win = 2 << (C.lane >> 4);
    for (int run = C_BID * NW + C.wave; run < M / 16; run += C_G * NW) {
        const int t0 = run * 16, p0 = t0 & (SEQ - 1);
        u32x4 cu[16], ou[16];
#pragma unroll
        for (int tt = 0; tt < 16; ++tt) cu[tt] = *((const u32x4*)(U + (size_t)(t0 + tt) * PW) + C.lane);
#pragma unroll
        for (int tt = 0; tt < 16; ++tt) { ou[tt] = (u32x4){0u, 0u, 0u, 0u}; if (p0 + tt - win + 1 >= 0) ou[tt] = *((const u32x4*)(U + (size_t)(t0 + tt - win + 1) * PW) + C.lane); }
        float s[8];
#pragma unroll
        for (int q = 0; q < 8; ++q) s[q] = 0.f;
        for (int h = 1; h < 16; ++h) if (h < win && p0 - h >= 0) { const u32x4 t = *((const u32x4*)(U + (size_t)(t0 - h) * PW) + C.lane);
            s[0] += bf_lo(t.x); s[1] += bf_hi(t.x); s[2] += bf_lo(t.y); s[3] += bf_hi(t.y); s[4] += bf_lo(t.z); s[5] += bf_hi(t.z); s[6] += bf_lo(t.w); s[7] += bf_hi(t.w); }
#pragma unroll
        for (int tt = 0; tt < 16; ++tt) {
            const int t = t0 + tt, p = p0 + tt; const u32x4 c4 = cu[tt], o = ou[tt];
            const float c[8] = {bf_lo(c4.x), bf_hi(c4.x), bf_lo(c4.y), bf_hi(c4.y), bf_lo(c4.z), bf_hi(c4.z), bf_lo(c4.w), bf_hi(c4.w)};
#pragma unroll
            for (int q = 0; q < 8; ++q) s[q] += c[q];
            const float inv = 1.0f / (float)((p + 1) < win ? (p + 1) : win);
            u32x4 r; r.x = cvt_pk_bf16(s[0] * inv - c[0], s[1] * inv - c[1]); r.y = cvt_pk_bf16(s[2] * inv - c[2], s[3] * inv - c[3]);
            r.z = cvt_pk_bf16(s[4] * inv - c[4], s[5] * inv - c[5]); r.w = cvt_pk_bf16(s[6] * inv - c[6], s[7] * inv - c[7]);
            *((u32x4*)(A2 + (size_t)t * D) + C.lane) = r;
            s[0] -= bf_lo(o.x); s[1] -= bf_hi(o.x); s[2] -= bf_lo(o.y); s[3] -= bf_hi(o.y); s[4] -= bf_lo(o.z); s[5] -= bf_hi(o.z); s[6] -= bf_lo(o.w); s[7] -= bf_hi(o.w);
        }
    }
}

constexpr int HQ_QT = 0, HQ_KH = 17408, HQ_KT = 34816, HQ_VT = 53248, HQ_ST = 71680, HQ_PP = 106496, HQ_TS = 115712, HQ_DC = 117760, HQ_ER = 118272, HQ_NS = 118784;
constexpr int HQ_OT = 0, OTP = 528;
static_assert(64 * OTP <= HQ_KT, "output staging fits over QT | KH");
constexpr int LD128 = 272, LD64 = 144;
template <bool OUT>
__device__ __forceinline__ void hgrn_item(Ctx& C, int item, const float* nw  ) {
    const int bh = item >> 5, j = item & 31, hh = bh & 3, row0 = (bh >> 2) * SEQ + j * 512;
    const int tid = C.tid, lane = C.lane, w = C.wave, fr = lane & 15, fq = lane >> 4;
    const int pk = tid & 127, pi = tid >> 7;
    LAS unsigned char* L = C.lds;
    const float* LFp = WSP(float, WS_LF) + hh * 128 + pk; const bf16_t* Qp = WSP(bf16_t, WS_Q) + hh * 128 + pk; const bf16_t* Vp = WSP(bf16_t, WS_V) + hh * 128 + pk;
    f32x4 acc[8];
    if (OUT) { const float* si = WSP(float, WS_SI) + (size_t)item * 16384;
#pragma unroll
        for (int vj = 0; vj < 8; ++vj)
#pragma unroll
            for (int r = 0; r < 4; ++r) acc[vj][r] = si[(16 * w + 4 * fq + r) * 128 + 16 * vj + fr];
    } else {
#pragma unroll
        for (int vj = 0; vj < 8; ++vj) acc[vj] = (f32x4){0.f, 0.f, 0.f, 0.f};
    }
    float gtot = 0.f; float lim80 = 80.f, eps_ = EPS; asm volatile("" : "+s"(lim80), "+s"(eps_));
    float lfA[16], lfB[16]; bf16_t vvA[16], vvB[16], qvA[16], qvB[16];
#define HG_ISSUE(LF_, VV_, QV_, cc) do { const int rbn_ = row0 + (cc) * 64 + 16 * pi; _Pragma("unroll") for (int t = 0; t < 16; ++t) { LF_[t] = LFp[(size_t)(rbn_ + t) * HW]; VV_[t] = Vp[(size_t)(rbn_ + t) * HW]; if (OUT) QV_[t] = Qp[(size_t)(rbn_ + t) * HW]; } } while (0)
    HG_ISSUE(lfA, vvA, qvA, 0);
    auto chunk = [&](float (&lf)[16], bf16_t (&vv)[16], bf16_t (&qv)[16], float (&lfn)[16], bf16_t (&vvn)[16], bf16_t (&qvn)[16], const int c) __attribute__((always_inline)) {
        const int m0 = row0 + c * 64;
        if (!OUT) { if (c < 7) HG_ISSUE(lfn, vvn, qvn, c + 1); }
        float Lc[16]; { float run = 0.f;
#pragma unroll
            for (int t = 0; t < 16; ++t) { run += lf[t]; Lc[t] = run; } }
        ((LAS float*)(L + HQ_TS))[pi * 128 + pk] = Lc[15];
        __syncthreads();
        const float t0 = ((LAS float*)(L + HQ_TS))[pk], t1 = ((LAS float*)(L + HQ_TS))[128 + pk], t2 = ((LAS float*)(L + HQ_TS))[256 + pk], t3 = ((LAS float*)(L + HQ_TS))[384 + pk];
        const float P2 = t0 + t1, P4 = (t0 + t1) + (t2 + t3), Pi = (pi > 0 ? t0 : 0.f) + (pi > 1 ? t1 : 0.f) + (pi > 2 ? t2 : 0.f);
        if (pi == 0) { ((LAS float*)(L + HQ_DC))[pk] = fast_exp(P4); ((LAS float*)(L + HQ_ER))[pk] = fast_exp(P2); gtot += P4; }
        unsigned ktp[8], vtp[8];
#pragma unroll
        for (int t = 0; t < 16; t += 2) {
            float kt2[2];
#pragma unroll
            for (int h = 0; h < 2; ++h) { const int tt = t + h; const float Gt = Pi + Lc[tt]; const float kk = 1.0f - fast_exp(lf[tt]);
                const float a = __builtin_amdgcn_fmed3f(Gt - P2, -lim80, lim80);
                if (OUT) { const float qf = bf2f(qv[tt]); const int trow = 16 * pi + tt;
                    *(LAS bf16_t*)(L + HQ_QT + trow * LD128 + pk * 2) = (bf16_t)(cvt_pk_bf16(qf * fast_exp(a), 0.f) & 0xffffu);
                    *(LAS bf16_t*)(L + HQ_KH + trow * LD128 + pk * 2) = (bf16_t)(cvt_pk_bf16(kk * fast_exp(-a), 0.f) & 0xffffu); }
                kt2[h] = kk * fast_exp(P4 - Gt); }
            ktp[t >> 1] = cvt_pk_bf16(kt2[0], kt2[1]); vtp[t >> 1] = (unsigned)vv[t] | ((unsigned)vv[t + 1] << 16);
        }
        { LAS u32x4* kd = (LAS u32x4*)(L + HQ_KT + pk * LD64 + pi * 32); kd[0] = (u32x4){ktp[0], ktp[1], ktp[2], ktp[3]}; kd[1] = (u32x4){ktp[4], ktp[5], ktp[6], ktp[7]};
          LAS u32x4* vd = (LAS u32x4*)(L + HQ_VT + pk * LD64 + pi * 32); vd[0] = (u32x4){vtp[0], vtp[1], vtp[2], vtp[3]}; vd[1] = (u32x4){vtp[4], vtp[5], vtp[6], vtp[7]}; }
        __syncthreads();
        bf16x8 aq[4]; u32x4 gw0, gw1; f32x4 nv[4];
        const int ti = w >> 1;
        if (OUT) {
            const f32x4 er = *(const LAS f32x4*)(L + HQ_ER + (16 * w + 4 * fq) * 4);
#pragma unroll
            for (int vj = 0; vj < 8; ++vj) { u32x2 p; p.x = cvt_pk_bf16(acc[vj][0] * er[0], acc[vj][1] * er[1]); p.y = cvt_pk_bf16(acc[vj][2] * er[2], acc[vj][3] * er[3]);
                *(LAS u32x2*)(L + HQ_ST + (16 * vj + fr) * LD128 + (16 * w + 4 * fq) * 2) = p; }
#pragma unroll
            for (int k2 = 0; k2 < 4; ++k2) aq[k2] = *(const LAS bf16x8*)(L + HQ_QT + (16 * ti + fr) * LD128 + (32 * k2 + 8 * fq) * 2);
#pragma unroll
            for (int q = 0; q < 2; ++q) { const int tj = 2 * (w & 1) + q; f32x4 sc = (f32x4){0.f, 0.f, 0.f, 0.f};
#pragma unroll
                for (int k2 = 0; k2 < 4; ++k2) { const bf16x8 bk = *(const LAS bf16x8*)(L + HQ_KH + (16 * tj + fr) * LD128 + (32 * k2 + 8 * fq) * 2); sc = __builtin_amdgcn_mfma_f32_16x16x32_bf16(aq[k2], bk, sc, 0, 0, 0); }
#pragma unroll
                for (int r = 0; r < 4; ++r) { const int t = 16 * ti + 4 * fq + r, s = 16 * tj + fr; const float pv = (s <= t) ? sc[r] : 0.f;
                    *(LAS bf16_t*)(L + HQ_PP + t * LD64 + s * 2) = (bf16_t)(cvt_pk_bf16(pv, 0.f) & 0xffffu); } }
            { const bf16_t* gp = WSP(bf16_t, WS_GG) + (size_t)(m0 + (tid >> 3)) * HW + hh * 128 + 16 * (tid & 7); gw0 = *(const u32x4*)gp; gw1 = *(const u32x4*)(gp + 8); }
            __syncthreads();
            { const int v0 = 16 * (tid & 7);
#pragma unroll
              for (int i = 0; i < 4; ++i) nv[i] = *(const f32x4*)(nw + v0 + 4 * i); }
            if (c < 7) HG_ISSUE(lfn, vvn, qvn, c + 1);
            bf16x8 ap[2];
#pragma unroll
            for (int k2 = 0; k2 < 2; ++k2) ap[k2] = *(const LAS bf16x8*)(L + HQ_PP + (16 * ti + fr) * LD64 + (32 * k2 + 8 * fq) * 2);
            float ss[4] = {0.f, 0.f, 0.f, 0.f};
#pragma unroll
            for (int q = 0; q < 4; ++q) { const int vj = 4 * (w & 1) + q; f32x4 ov = (f32x4){0.f, 0.f, 0.f, 0.f};
#pragma unroll
                for (int k2 = 0; k2 < 2; ++k2) { const bf16x8 bv = *(const LAS bf16x8*)(L + HQ_VT + (16 * vj + fr) * LD64 + (32 * k2 + 8 * fq) * 2); ov = __builtin_amdgcn_mfma_f32_16x16x32_bf16(ap[k2], bv, ov, 0, 0, 0); }
#pragma unroll
                for (int k2 = 0; k2 < 4; ++k2) { const bf16x8 bs = *(const LAS bf16x8*)(L + HQ_ST + (16 * vj + fr) * LD128 + (32 * k2 + 8 * fq) * 2); ov = __builtin_amdgcn_mfma_f32_16x16x32_bf16(aq[k2], bs, ov, 0, 0, 0); }
#pragma unroll
                for (int r = 0; r < 4; ++r) { *(LAS float*)(L + HQ_OT + (16 * ti + 4 * fq + r) * OTP + (16 * vj + fr) * 4) = ov[r]; ss[r] += ov[r] * ov[r]; } }
#pragma unroll
            for (int r = 0; r < 4; ++r) { float s = ss[r]; s += shfl_xor_l(s, 1, lane); s += shfl_xor_l(s, 2, lane); s += shfl_xor_l(s, 4, lane); s += shfl_xor_l(s, 8, lane);
                if (fr == 0) ((LAS float*)(L + HQ_NS))[(16 * ti + 4 * fq + r) * 2 + (w & 1)] = s; }
        }
        {
            bf16x8 ak[2];
#pragma unroll
            for (int k2 = 0; k2 < 2; ++k2) ak[k2] = *(const LAS bf16x8*)(L + HQ_KT + (16 * w + fr) * LD64 + (32 * k2 + 8 * fq) * 2);
            const f32x4 dc = *(const LAS f32x4*)(L + HQ_DC + (16 * w + 4 * fq) * 4);
#pragma unroll
            for (int vj = 0; vj < 8; ++vj) { f32x4 a = acc[vj] * dc;
#pragma unroll
                for (int k2 = 0; k2 < 2; ++k2) { const bf16x8 bv = *(const LAS bf16x8*)(L + HQ_VT + (16 * vj + fr) * LD64 + (32 * k2 + 8 * fq) * 2); a = __builtin_amdgcn_mfma_f32_16x16x32_bf16(ak[k2], bv, a, 0, 0, 0); }
                acc[vj] = a; }
        }
        __syncthreads();
        if (OUT) {
            { const int t = tid >> 3, v0 = 16 * (tid & 7);
              const float tot = ((LAS float*)(L + HQ_NS))[t * 2] + ((LAS float*)(L + HQ_NS))[t * 2 + 1]; const float rs = 1.0f / sqrtf(tot * (1.0f / 128.0f) + eps_);
              f32x4 ox[4];
#pragma unroll
              for (int i = 0; i < 4; ++i) ox[i] = *(const LAS f32x4*)(L + HQ_OT + t * OTP + (v0 + 4 * i) * 4);
              const float g[16] = {bf_lo(gw0.x), bf_hi(gw0.x), bf_lo(gw0.y), bf_hi(gw0.y), bf_lo(gw0.z), bf_hi(gw0.z), bf_lo(gw0.w), bf_hi(gw0.w), bf_lo(gw1.x), bf_hi(gw1.x), bf_lo(gw1.y), bf_hi(gw1.y), bf_lo(gw1.z), bf_hi(gw1.z), bf_lo(gw1.w), bf_hi(gw1.w)};
              float y[16];
#pragma unroll
              for (int i = 0; i < 4; ++i)
#pragma unroll
                  for (int e = 0; e < 4; ++e) y[4 * i + e] = ox[i][e] * rs * nv[i][e] * g[4 * i + e];
              u32x4 w0, w1; w0.x = cvt_pk_bf16(y[0], y[1]); w0.y = cvt_pk_bf16(y[2], y[3]); w0.z = cvt_pk_bf16(y[4], y[5]); w0.w = cvt_pk_bf16(y[6], y[7]);
              w1.x = cvt_pk_bf16(y[8], y[9]); w1.y = cvt_pk_bf16(y[10], y[11]); w1.z = cvt_pk_bf16(y[12], y[13]); w1.w = cvt_pk_bf16(y[14], y[15]);
              bf16_t* op = WSP(bf16_t, WS_A2) + (size_t)(m0 + t) * D + 512 + hh * 128 + v0; *(u32x4*)op = w0; *(u32x4*)(op + 8) = w1; }
        }
    };
    if (OUT) { for (int c = 0; c < 8; ++c) chunk(lfA, vvA, qvA, lfA, vvA, qvA, c); }
    else { for (int c = 0; c < 8; c += 2) { chunk(lfA, vvA, qvA, lfB, vvB, qvB, c); chunk(lfB, vvB, qvB, lfA, vvA, qvA, c + 1); } }
#undef HG_ISSUE
    if (!OUT) { float* sl = WSP(float, WS_SL) + (size_t)item * 16384;
#pragma unroll
        for (int vj = 0; vj < 8; ++vj)
#pragma unroll
            for (int r = 0; r < 4; ++r) sl[(16 * w + 4 * fq + r) * 128 + 16 * vj + fr] = acc[vj][r];
        if (pi == 0) SMP(float, SM_DT)[item * 128 + pk] = fast_exp(gtot); }
}
__device__ __forceinline__ void phase_scan(Ctx& C) {
    const float* SL = WSP(float, WS_SL); float* SI = WSP(float, WS_SI); const float* DT = SMP(float, SM_DT);
    for (int gid = C_BID * NT + C.tid; gid < 8 * 16384; gid += C_G * NT) {
        const int bh = gid >> 14, e = gid & 16383, k = e >> 7; float s = 0.f;
        float sl[31], dt[31];
#pragma unroll
        for (int j = 0; j < 31; ++j) { const size_t it = (size_t)(bh * 32 + j); sl[j] = SL[it * 16384 + e]; dt[j] = DT[it * 128 + k]; }
#pragma unroll
        for (int j = 0; j < 32; ++j) { SI[(size_t)(bh * 32 + j) * 16384 + e] = s; if (j < 31) s = dt[j] * s + sl[j]; }
    }
}

constexpr int NSTAGES = 26;

__global__ void __launch_bounds__(NT, 2) fwd(Args a) {
    extern __shared__ __attribute__((aligned(16))) unsigned char lds_raw[];
    Ctx C;
    C.lds = (LAS unsigned char*)lds_raw; C.tid = threadIdx.x; C.lane = C.tid & 63; C.wave = __builtin_amdgcn_readfirstlane(C.tid >> 6);
    int wave_s = C.wave;
    C.a = (const CAS Args*)__builtin_amdgcn_kernarg_segment_ptr();
    volatile LAS unsigned* MISC = (volatile LAS unsigned*)(C.lds + MISC_OFF);
    if (C.tid < 64) MISC[C.tid] = 0u;
    __syncthreads();
#if N_LAUNCHES == 1
    const int lo = 0, hi = NSTAGES;
    (void)xcd_barrier_post((unsigned*)(C_WS + WS_CTL) + CW_BAR, MISC + 8, C.tid);
#define SEAM() do { if (st + 1 < NSTAGES) { XcdBarrier bar_; bar_.bar = (unsigned*)(C_WS + WS_CTL) + CW_BAR; bar_.x = xb_xcc_id(); bar_.st = (volatile LAS unsigned*)(C.lds + MISC_OFF) + 8; unsigned mb_ = ~0u; asm volatile("" : "+s"(mb_), "+s"(wave_s)); const int tid_b = wave_s * 64 + (int)__builtin_amdgcn_mbcnt_hi(mb_, __builtin_amdgcn_mbcnt_lo(mb_, 0u)); xcd_barrier(bar_, tid_b); } } while (0)
#else
    const int lo = C.a->lo, hi = C.a->hi;
#define SEAM() do { } while (0)
#endif
    int st = 0;
#define STAGE_BEGIN(k) if (st >= lo && st < hi) { { unsigned m_ = ~0u; asm volatile("" : "+s"(m_), "+s"(wave_s)); C.lane = (int)__builtin_amdgcn_mbcnt_hi(m_, __builtin_amdgcn_mbcnt_lo(m_, 0u)); C.wave = wave_s; C.tid = wave_s * 64 + C.lane; } asm volatile("" : "+s"(C.a)); asm volatile("" : "+s"(C.lds)); C.G = gridDim.x; C.bid = blockIdx.x; asm volatile("" : "+s"(C.G), "+s"(C.bid));
#define STAGE_END } if (st >= lo && st < hi) { SEAM(); } ++st;
#define Hb WSP(bf16_t, WS_H)
    constexpr unsigned T1K = 256u * 1024 * 2;


    for (int l = 0; l < 2; ++l) {
        STAGE_BEGIN(1) if (l == 0) { phase_prologue(C); __syncthreads(); }
            phase_norm(C, l == 0 ? CIN(0) : C_OUT, l == 0 ? nullptr : C_OUT, CIN(1) + l * D, Hb, nullptr, WSP(bf16_t, WS_DN0), nullptr, l, nullptr, C_WS + WS_H8); STAGE_END
        STAGE_BEGIN(2) {
            {
                pg8::Gemm g{(const char*)C_WS, D, D, D};
                GridOrder S{(unsigned)WS_H, (unsigned)WS_WIN + (unsigned)l * (INC * D * 2), T1K, T1K, M / 256, (INC - NGATE) / 256, C_G, C_BID};
                EpiIn E{C_WS, CIN(3) + l * NGATE, l};
                pg8::gemm_phase<false>(C.lds, g, S, E, C.tid);
            }
            {
                pg8::Gemm g{(const char*)C_WS, D / 2, D / 2, D / 2};
                GridOrder S{(unsigned)WS_H8, (unsigned)WS_WG8 + (unsigned)l * (NGATE * D), 256u * D, 256u * D, M / 256, NGATE / 256, C_G, C_BID};
                EpiGate8 E{C_WS, CIN(3) + l * NGATE, 1.0f / (F8_H * F8_W)};
                pg8::gemm_phase<true>(C.lds, g, S, E, C.tid);
            }
        } STAGE_END
        STAGE_BEGIN(3) phase_pool(C); __syncthreads(); for (int it = C_BID; it < 256; it += C_G) hgrn_item<false>(C, it, nullptr); STAGE_END
        STAGE_BEGIN(4) phase_scan(C); STAGE_END
        STAGE_BEGIN(5) for (int it = C_BID; it < 256; it += C_G) hgrn_item<true>(C, it, CIN(8) + l * 128); STAGE_END
        STAGE_BEGIN(6) {
            pg8::Gemm g{(const char*)C_WS, D, D, 512};
            UOrder S{(unsigned)WS_A2, (unsigned)WS_WU + (unsigned)l * (D * D * 2), C_G, C_BID};
            EpiU E{C_WS};
            pg8::gemm_phase<false>(C.lds, g, S, E, C.tid);
        } STAGE_END
        STAGE_BEGIN(7) {
            pg8::Gemm g{(const char*)C_WS, D, D, D};
            GridOrder S{(unsigned)WS_H, (unsigned)WS_WOUT + (unsigned)l * (D * D * 2), T1K, T1K, M / 256, D / 256, C_G, C_BID};
            EpiRow E{WSP(bf16_t, WS_MO), D, nullptr, 1.0f};
            pg8::gemm_phase<false>(C.lds, g, S, E, C.tid);
        } STAGE_END
        STAGE_BEGIN(8) if (l == 0) phase_norm(C, CIN(0), C_OUT, CIN(11), Hb, nullptr, WSP(bf16_t, WS_MO), nullptr, 1, nullptr, nullptr);
            else { phase_norm_router(C, C_OUT, CIN(11) + D, WSP(bf16_t, WS_MO), C_WS + WS_H, CIN(15));     __syncthreads(); phase_moe_weights(C); } STAGE_END
        if (l == 1) {
            STAGE_BEGIN(9) phase_route(C); STAGE_END
            STAGE_BEGIN(10) phase_gather(C); STAGE_END
        }
        if (l == 0) {
            STAGE_BEGIN(11) {
                pg8::Gemm g{(const char*)C_WS, D, D, D};
                GuOrder S{(unsigned)WS_H, (unsigned)WS_DGU, nullptr, 0u, T1K, 0, 128, DFF0 / 128, C_G, C_BID};
                EpiSwi E{WSP(bf16_t, WS_ACT0), DFF0};
                pg8::gemm_phase<false>(C.lds, g, S, E, C.tid);
            } STAGE_END
            STAGE_BEGIN(12) {
                pg8::Gemm g{(const char*)C_WS, DFF0, DFF0, DFF0};
                DownOrder S{(unsigned)WS_ACT0, (unsigned)WS_DDN, nullptr, 0u, 256u * DFF0 * 2u, 0, 128, C_G, C_BID};
                EpiRow E{WSP(bf16_t, WS_DN0), D, nullptr, 1.0f};
                pg8::gemm_phase<false>(C.lds, g, S, E, C.tid);
            } STAGE_END
        } else {
            for (int gi = 0; gi < MOE_NG; ++gi) {
#define MOE_PARAMS() const int* texp = SMP(int, SM_TILEEXP); const int ntl = __builtin_amdgcn_readfirstlane(__hip_atomic_load(SMP(int, SM_NT), __ATOMIC_RELAXED, __HIP_MEMORY_SCOPE_AGENT)); \
                const int t0 = gi * MOE_G0; int nT = gi == 0 ? (ntl < MOE_G0 ? ntl : MOE_G0) : (ntl - MOE_G0); nT = nT < 0 ? 0 : nT;
                STAGE_BEGIN(14) {
                    MOE_PARAMS()
                    pg8::Gemm g{(const char*)C_WS, D / 2, D / 2, D / 2};
                    GuOrder S{(unsigned)WS_H2G, (unsigned)WS_MW, texp, (unsigned)MW_GU_E, 256u * D, t0, nT, DFF1 / 128, C_G, C_BID};
                    EpiSwi8 E{C_WS + WS_ACT1, DFF1, 1.0f / (F8_H * F8_W), F8_A};
                    pg8::gemm_phase<true>(C.lds, g, S, E, C.tid);
                } STAGE_END
                STAGE_BEGIN(15) {
                    MOE_PARAMS()
                    const int nTd = nT > 128 ? 128 : nT;
                    pg8::Gemm g{(const char*)C_WS, DFF1 / 2, DFF1 / 2, DFF1 / 2};
                    DownOrder S{(unsigned)WS_ACT1, (unsigned)WS_MWD, texp, (unsigned)MW_DN_E, 256u * DFF1, t0, nTd, C_G, C_BID};
                    EpiRow E{WSP(bf16_t, WS_DN1), D, SMP(float, SM_ROWSC), 1.0f / (F8_A * F8_W)};
                    pg8::gemm_phase<true>(C.lds, g, S, E, C.tid);
                } STAGE_END
            }
        }
    }
    STAGE_BEGIN(16) {
        const int* texp = SMP(int, SM_TILEEXP); const int ntl = __builtin_amdgcn_readfirstlane(__hip_atomic_load(SMP(int, SM_NT), __ATOMIC_RELAXED, __HIP_MEMORY_SCOPE_AGENT));
        const int nTt = ntl > 256 ? ntl - 256 : 0;
        {
            pg8::Gemm g{(const char*)C_WS, DFF1 / 2, DFF1 / 2, DFF1 / 2};
            DownOrder S{(unsigned)WS_ACT1 + 128u * (256u * DFF1), (unsigned)WS_MWD, texp, (unsigned)MW_DN_E, 256u * DFF1, 256, nTt, C_G, C_BID};
            EpiRow E{WSP(bf16_t, WS_DN1), D, SMP(float, SM_ROWSC), 1.0f / (F8_A * F8_W)};
            pg8::gemm_phase<true>(C.lds, g, S, E, C.tid);
        }
        phase_final(C, 1, nTt * 4);
    } STAGE_END
    STAGE_BEGIN(13) phase_final(C, 2, 0); STAGE_END
}


extern "C" void kernel_launch(void* const* d_in, const int* in_sizes, int n_in, void* d_out, int out_size, void* d_ws, size_t ws_size, hipStream_t stream) {
    static int grid = 0;
    if (grid == 0) {
        if (n_in != 20 || in_sizes[0] != M * D || out_size != M * D || ws_size < WS_END) { fprintf(stderr, "kernel_launch: unexpected sizes (n_in %d, out %d, ws %zu < %zu)\n", n_in, out_size, ws_size, (size_t)WS_END); grid = -1; return; }
        int dev = 0, cus = 0;
        if (hipGetDevice(&dev) != hipSuccess || hipDeviceGetAttribute(&cus, hipDeviceAttributeMultiprocessorCount, dev) != hipSuccess) { grid = -1; return; }
        if (hipFuncSetAttribute((const void*)fwd, hipFuncAttributeMaxDynamicSharedMemorySize, LDS_BYTES) != hipSuccess) { fprintf(stderr, "kernel_launch: hipFuncSetAttribute failed\n"); grid = -1; return; }
        int per_cu = 0;
        if (hipOccupancyMaxActiveBlocksPerMultiprocessor(&per_cu, (const void*)fwd, NT, LDS_BYTES) != hipSuccess || per_cu < 1) fprintf(stderr, "kernel_launch: occupancy query reports %d blocks per CU\n", per_cu);
        (void)hipGetLastError();
        if (cus != 256) { fprintf(stderr, "kernel_launch: built for a 256-CU device, found %d\n", cus); grid = -1; return; }
        grid = cus;
    }
    if (grid < 0) return;
    if (hipMemsetAsync((char*)d_ws + WS_CTL, 0, CTL_BYTES, stream) != hipSuccess) return;
    Args a{};
    for (int i = 0; i < 20; ++i) a.in[i] = (const float*)d_in[i];
    a.out = (float*)d_out; a.ws = (unsigned char*)d_ws;
#if N_LAUNCHES == 1
    a.lo = 0; a.hi = NSTAGES;
    hipLaunchKernelGGL(fwd, dim3(grid), dim3(NT), LDS_BYTES, stream, a);
#else
    for (int s = 0; s < NSTAGES; ++s) { a.lo = s; a.hi = s + 1; hipLaunchKernelGGL(fwd, dim3(grid), dim3(NT), LDS_BYTES, stream, a); }

#endif
}
```

```cpp
#include <hip/hip_runtime.h>
#include <cstdio>
#include <cstdint>

#ifndef N_LAUNCHES
#define N_LAUNCHES 1
#endif

#define GAS __attribute__((address_space(1)))
#define LAS __attribute__((address_space(3)))
typedef unsigned short bf16_t;
typedef short bf16x8 __attribute__((ext_vector_type(8)));
typedef float f32x4 __attribute__((ext_vector_type(4)));
typedef float f32x2 __attribute__((ext_vector_type(2)));
typedef unsigned u32x4 __attribute__((ext_vector_type(4)));
typedef unsigned u32x2 __attribute__((ext_vector_type(2)));
typedef int i32x4 __attribute__((ext_vector_type(4)));
typedef int i32x8 __attribute__((ext_vector_type(8)));

constexpr int BATCH = 2, SEQ = 16384, D = 1024, M = BATCH * SEQ;
constexpr int PW = 512, HW = 512, INC = 4608, NGATE = 2048;
constexpr int DFF0 = 2816, DFF1 = 3584, NEXP = 8;
constexpr float EPS = 1e-6f;
constexpr int MAXTILES = 320;
constexpr int MAXSLOTS = MAXTILES * 256;

typedef __bf16 bf16x2_t __attribute__((ext_vector_type(2)));
__device__ __forceinline__ unsigned cvt_pk_bf16(float lo, float hi) { const bf16x2_t v = __builtin_convertvector((f32x2){lo, hi}, bf16x2_t); return __builtin_bit_cast(unsigned, v); }
__device__ __forceinline__ float f8_limit() { float l = 448.0f; asm volatile("" : "+s"(l)); return l; }
__device__ __forceinline__ float clamp_f8(float x, float lim) { return __builtin_amdgcn_fmed3f(x, -lim, lim); }
__device__ __forceinline__ unsigned pk4_fp8(float a, float b, float c, float d, float lim) {
    unsigned w = 0u; w = __builtin_amdgcn_cvt_pk_fp8_f32(clamp_f8(a, lim), clamp_f8(b, lim), w, false); w = __builtin_amdgcn_cvt_pk_fp8_f32(clamp_f8(c, lim), clamp_f8(d, lim), w, true); return w; }
__device__ __forceinline__ float bf_lo(unsigned w) { return __uint_as_float(w << 16); }
__device__ __forceinline__ float bf_hi(unsigned w) { return __uint_as_float(w & 0xffff0000u); }
__device__ __forceinline__ float bf2f(bf16_t b) { return __uint_as_float(((unsigned)b) << 16); }
__device__ __forceinline__ float fast_rcp(float x) { return __builtin_amdgcn_rcpf(x); }
__device__ __forceinline__ float fast_exp(float x) { return __builtin_amdgcn_exp2f(x * 1.44269504088896f); }
__device__ __forceinline__ float sigmoidf_(float x) { return fast_rcp(1.0f + fast_exp(-x)); }
__device__ __forceinline__ float siluf_(float x) { return x * sigmoidf_(x); }
__device__ __forceinline__ f32x2 sigmoid2(f32x2 x) { const f32x2 t = x * (f32x2){-1.44269504088896f, -1.44269504088896f}; f32x2 e; e.x = __builtin_amdgcn_exp2f(t.x); e.y = __builtin_amdgcn_exp2f(t.y);
    const f32x2 d = e + (f32x2){1.0f, 1.0f}; f32x2 r; r.x = __builtin_amdgcn_rcpf(d.x); r.y = __builtin_amdgcn_rcpf(d.y); return r; }
__device__ __forceinline__ f32x4 sigmoid4(f32x4 x) { const f32x2 a = sigmoid2((f32x2){x[0], x[1]}), b = sigmoid2((f32x2){x[2], x[3]}); return (f32x4){a.x, a.y, b.x, b.y}; }
__device__ __forceinline__ f32x4 silu4(f32x4 x) { return x * sigmoid4(x); }

namespace pg8 {
constexpr int BM = 256, BK = 64, HALF = 128, HTB = HALF * BK * 2, STAGE_BYTES = 8 * HTB, NXCD = 8, WGM = 8;
__host__ __device__ __forceinline__ int lds_byte(int r, int c) { const int st = (r >> 4) * 2 + (c >> 5), rr = r & 15, cc = c & 31, ob = rr * 64 + cc * 2; return st * 1024 + (ob ^ (((ob >> 9) & 1) << 5)); }
__host__ __device__ __forceinline__ void stage_rc(int b, int& R, int& C) { const int st = b / 1024, sb = b % 1024, swz = sb ^ (((sb >> 9) & 1) << 5); R = (st >> 1) * 16 + swz / 64; C = (st & 1) * 32 + (swz % 64) / 2; }
__host__ __device__ __forceinline__ int perm32(int rho) { const int n = rho >> 4, i = rho & 15; return 8 * (i >> 2) + 4 * n + (i & 3); }

struct Unit { unsigned A, B; int pm, pn, x; };
struct Gemm { const char* base; int lda, ldb, K; };

__device__ __forceinline__ bool grid_tile(int L, int nM, int nN, int& pm, int& pn) {
    const int nwg = nM * nN; if (L >= nwg) return false;
    int wgid = L; { const int q = nwg / NXCD, r = nwg % NXCD, xcd = wgid % NXCD, off = wgid / NXCD; wgid = (xcd < r ? xcd * (q + 1) : r * (q + 1) + (xcd - r) * q) + off; }
    const int nig = WGM * nN, gid = wgid / nig, fm = gid * WGM, gsz = (nM - fm) < WGM ? (nM - fm) : WGM;
    pm = fm + ((wgid % nig) % gsz); pn = (wgid % nig) / gsz; return true;
}

template <bool FP8, class Epi, class Sched>
__device__ __forceinline__ void gemm_phase(LAS unsigned char* lds, const Gemm g, const Sched& S, const Epi& E, int tid_in) {
    int tid_ = tid_in; asm volatile("" : "+v"(tid_));
    const int tid = tid_, wid = __builtin_amdgcn_readfirstlane(tid >> 6), lane = tid & 63, wr = wid >> 2, wc = wid & 3, fr = lane & 15, fq = lane >> 4;
    const int K = g.K, nt = K / BK;
    unsigned voffA, voffB;
    { int R, C; stage_rc(tid * 16, R, C); const int Rb = (R & ~31) + perm32(R & 31); voffA = (unsigned)(R * g.lda + C) * 2u; voffB = (unsigned)(Rb * g.ldb + C) * 2u; }
    const unsigned piecevoffA = 64u * (unsigned)g.lda * 2u, piecevoffB = 64u * (unsigned)g.ldb * 2u;
    const unsigned kstep = (unsigned)(BK * 2);
    const unsigned hstepA = (unsigned)HALF * g.lda * 2u, hstepB = (unsigned)HALF * g.ldb * 2u;
    const char* const gb = g.base;
    const unsigned ldsw = (unsigned)wid * 1024u;
    const int aoff = lds_byte(wr * 64 + fr, fq * 8), boff = lds_byte(wc * 32 + fr, fq * 8);
#define PG8_SA(b, h) (((b) * 2 + (h)) * HTB)
#define PG8_SB(b, h) ((4 + (b) * 2 + (h)) * HTB)
#define PG8_STAGE2(bufoff, gbase, voff, piece) do { _Pragma("unroll") for (int _i = 0; _i < 2; ++_i) \
        __builtin_amdgcn_global_load_lds((const unsigned*)((gb + (size_t)(unsigned)((gbase) + _i * (piece))) + (size_t)(voff)), (LAS unsigned*)(lds + (bufoff) + ldsw + _i * 8192), 16, 0, 0); } while (0)
#define PG8_STAGE(bufoff, gbase, voff) PG8_STAGE2(bufoff, gbase, voff, piece##voff)
#define PG8_LDA(dst, b, h) do { _Pragma("unroll") for (int m = 0; m < 4; ++m) _Pragma("unroll") for (int k = 0; k < 2; ++k) dst[m][k] = *(const LAS bf16x8*)(lds + PG8_SA(b, h) + aoff + m * 2048 + k * 1024); } while (0)
#define PG8_LDB(dst, b, h) do { _Pragma("unroll") for (int n = 0; n < 2; ++n) _Pragma("unroll") for (int k = 0; k < 2; ++k) dst[n][k] = *(const LAS bf16x8*)(lds + PG8_SB(b, h) + boff + n * 2048 + k * 1024); } while (0)
#define PG8_CAT(lo, hi) __builtin_shufflevector(__builtin_bit_cast(i32x4, lo), __builtin_bit_cast(i32x4, hi), 0, 1, 2, 3, 4, 5, 6, 7)
#define PG8_MMA(ai, bj, At, Bt) do { __builtin_amdgcn_s_setprio(1); _Pragma("unroll") for (int m = 0; m < 4; ++m) _Pragma("unroll") for (int n = 0; n < 2; ++n) { \
        if constexpr (FP8) acc[ai][bj][m][n] = __builtin_amdgcn_mfma_scale_f32_16x16x128_f8f6f4(PG8_CAT(Bt[n][0], Bt[n][1]), PG8_CAT(At[m][0], At[m][1]), acc[ai][bj][m][n], 0, 0, 0, 0, 0, 0);     \
        else { _Pragma("unroll") for (int k = 0; k < 2; ++k) acc[ai][bj][m][n] = __builtin_amdgcn_mfma_f32_16x16x32_bf16(Bt[n][k], At[m][k], acc[ai][bj][m][n], 0, 0, 0); } } \
        __builtin_amdgcn_s_setprio(0); } while (0)
#define PG8_WAIT_V(n) asm volatile("s_waitcnt vmcnt(" #n ")" ::: "memory")
#define PG8_WAIT_L(n) asm volatile("s_waitcnt lgkmcnt(" #n ")" ::: "memory")
#define PG8_BAR __builtin_amdgcn_s_barrier()
#define PG8_SCHED __builtin_amdgcn_sched_barrier(0)
    Unit cur, nxt; int ui = 0;
    if (!S.next(0, cur)) return;
    f32x4 acc[2][2][4][2];
#pragma unroll
    for (int a = 0; a < 2; ++a)
#pragma unroll
        for (int b = 0; b < 2; ++b)
#pragma unroll
            for (int m = 0; m < 4; ++m)
#pragma unroll
                for (int n = 0; n < 2; ++n) acc[a][b][m][n] = (f32x4){0.f, 0.f, 0.f, 0.f};
    bf16x8 At[4][2], B0[2][2], B1[2][2];
    unsigned cA = cur.A, cB = cur.B;
    PG8_STAGE(PG8_SB(0, 0), cB, voffB); PG8_STAGE(PG8_SB(0, 1), cB + hstepB, voffB); PG8_STAGE(PG8_SA(0, 0), cA, voffA); PG8_STAGE(PG8_SA(0, 1), cA + hstepA, voffA);
    if (wr == 1) PG8_BAR;
    PG8_WAIT_V(2); PG8_BAR;
    PG8_STAGE(PG8_SB(1, 0), cB + kstep, voffB); PG8_STAGE(PG8_SA(1, 0), cA + kstep, voffA); PG8_STAGE(PG8_SB(1, 1), cB + hstepB + kstep, voffB);
    PG8_WAIT_V(6); PG8_BAR;
    for (;;) {
        const bool has_next = S.next(ui + 1, nxt);
        const unsigned nA = has_next ? nxt.A : cA, nB = has_next ? nxt.B : cB;
#pragma unroll 1
        for (int t = 0; t < nt; t += 2) {
            const bool last = (t == nt - 2);
            const unsigned a1 = cA + (unsigned)(t + 1) * kstep;
            const unsigned a2 = last ? nA : cA + (unsigned)(t + 2) * kstep, b2 = last ? nB : cB + (unsigned)(t + 2) * kstep;
            const unsigned a3 = a2 + kstep, b3 = b2 + kstep;
            const bool relax = (t == 0) && (ui > 0);
#define PG8_WAIT_FIRST() do { if (relax) { if constexpr (Epi::NST == 8) PG8_WAIT_V(16); else PG8_WAIT_V(24); } else PG8_WAIT_V(8); } while (0)
            PG8_LDB(B0, 0, 0); PG8_LDB(B1, 0, 1); PG8_SCHED; PG8_LDA(At, 0, 0); PG8_STAGE(PG8_SA(1, 1), a1 + hstepA, voffA);
            PG8_WAIT_FIRST(); PG8_WAIT_L(0); PG8_BAR; PG8_MMA(0, 0, At, B0); PG8_MMA(0, 1, At, B1); PG8_BAR; PG8_SCHED;
            PG8_LDA(At, 0, 1); PG8_STAGE(PG8_SB(0, 0), b2, voffB); PG8_STAGE(PG8_SB(0, 1), b2 + hstepB, voffB); PG8_STAGE(PG8_SA(0, 0), a2, voffA);
            PG8_WAIT_FIRST(); PG8_WAIT_L(0); PG8_BAR; PG8_MMA(1, 0, At, B0); PG8_MMA(1, 1, At, B1); PG8_BAR; PG8_SCHED;
            PG8_LDB(B0, 1, 0); PG8_LDB(B1, 1, 1); PG8_SCHED; PG8_LDA(At, 1, 0); PG8_STAGE(PG8_SA(0, 1), a2 + hstepA, voffA);
            PG8_WAIT_V(8); PG8_WAIT_L(0); PG8_BAR; PG8_MMA(0, 0, At, B0); PG8_MMA(0, 1, At, B1); PG8_BAR; PG8_SCHED;
            PG8_LDA(At, 1, 1); PG8_STAGE(PG8_SB(1, 0), b3, voffB); PG8_STAGE(PG8_SB(1, 1), b3 + hstepB, voffB); PG8_STAGE(PG8_SA(1, 0), a3, voffA);
            PG8_WAIT_V(8); PG8_WAIT_L(0); PG8_BAR; PG8_MMA(1, 0, At, B0); PG8_MMA(1, 1, At, B1); PG8_BAR; PG8_SCHED;
        }
        if (wr == 0) PG8_BAR;
        E(acc, cur, wr, wc, fr, fq);
        if (!has_next) break;
#pragma unroll
        for (int a = 0; a < 2; ++a)
#pragma unroll
            for (int b = 0; b < 2; ++b)
#pragma unroll
                for (int m = 0; m < 4; ++m)
#pragma unroll
                    for (int n = 0; n < 2; ++n) acc[a][b][m][n] = (f32x4){0.f, 0.f, 0.f, 0.f};
        cur = nxt; cA = nA; cB = nB; ++ui;
        if (wr == 1) PG8_BAR;
    }
    PG8_WAIT_V(0);
    PG8_BAR;
#undef PG8_SA
#undef PG8_SB
#undef PG8_STAGE
#undef PG8_STAGE2
#undef PG8_LDA
#undef PG8_LDB
#undef PG8_MMA
#undef PG8_WAIT_FIRST
#undef PG8_CAT
#undef PG8_WAIT_V
#undef PG8_WAIT_L
#undef PG8_BAR
#undef PG8_SCHED
}
}

constexpr size_t EPI_MiB = 1u << 20;
constexpr size_t EPI_WS_U = 111 * EPI_MiB, EPI_WS_Q = 143 * EPI_MiB, EPI_WS_LF = 175 * EPI_MiB, EPI_WS_V = 239 * EPI_MiB, EPI_WS_GG = 271 * EPI_MiB, EPI_WS_GT = 303 * EPI_MiB, EPI_WS_H = 47 * EPI_MiB, EPI_WS_LB = 1 * EPI_MiB;
typedef f32x4 AccT[2][2][4][2];
#define EPI_ROW0(u) ((u).pm * 256 + wr * 64 + fr)
__device__ __forceinline__ u32x4 pack8(const f32x4 a, const f32x4 b) { u32x4 w; w.x = cvt_pk_bf16(a[0], a[1]); w.y = cvt_pk_bf16(a[2], a[3]); w.z = cvt_pk_bf16(b[0], b[1]); w.w = cvt_pk_bf16(b[2], b[3]); return w; }

struct EpiIn {
    static constexpr int NST = 16;
    unsigned char* ws; const float* gbias; int layer;
    __device__ __forceinline__ void operator()(const AccT& acc, const pg8::Unit& u, int wr, int wc, int fr, int fq) const {
        unsigned char* wb = ws; asm volatile("" : "+s"(wb));
        GAS unsigned char* const wg = (GAS unsigned char*)wb;
        GAS bf16_t* const U = (GAS bf16_t*)(wg + EPI_WS_U); GAS bf16_t* const Q = (GAS bf16_t*)(wg + EPI_WS_Q); GAS bf16_t* const V = (GAS bf16_t*)(wg + EPI_WS_V); GAS bf16_t* const G = (GAS bf16_t*)(wg + EPI_WS_GG); GAS bf16_t* const GT = (GAS bf16_t*)(wg + EPI_WS_GT);
        GAS float* const LF = (GAS float*)(wg + EPI_WS_LF); const GAS float* const lb = (const GAS float*)(wg + EPI_WS_LB) + layer * HW;
        const int row0 = EPI_ROW0(u), cw = wc * 32 + 8 * fq;
        if (u.pn >= 10) {
            const int c0 = (u.pn - 10) * 256 + cw;
            f32x4 bb[2][2];
#pragma unroll
            for (int bj = 0; bj < 2; ++bj) { bb[bj][0] = *(const f32x4*)(gbias + c0 + bj * 128); bb[bj][1] = *(const f32x4*)(gbias + c0 + bj * 128 + 4); }
#pragma unroll
            for (int bj = 0; bj < 2; ++bj) { const int c = c0 + bj * 128; const f32x4 b0 = bb[bj][0], b1 = bb[bj][1];
#pragma unroll
                for (int ai = 0; ai < 2; ++ai)
#pragma unroll
                    for (int m = 0; m < 4; ++m) { f32x4 v0 = acc[ai][bj][m][0] + b0, v1 = acc[ai][bj][m][1] + b1;
#pragma unroll
                        for (int j = 0; j < 4; ++j) { v0[j] = sigmoidf_(v0[j]); v1[j] = sigmoidf_(v1[j]); }
                        *(GAS u32x4*)(GT + (size_t)(row0 + ai * 128 + m * 16) * NGATE + c) = pack8(v0, v1); } }
        } else if ((u.pn >> 1) == 2) {
            const int c0 = (u.pn - 4) * 256 + cw;
            f32x4 ll[2][2];
#pragma unroll
            for (int bj = 0; bj < 2; ++bj) { ll[bj][0] = *(const GAS f32x4*)(lb + c0 + bj * 128); ll[bj][1] = *(const GAS f32x4*)(lb + c0 + bj * 128 + 4); }
#pragma unroll
            for (int bj = 0; bj < 2; ++bj) { const int c = c0 + bj * 128; const f32x4 l0 = ll[bj][0], l1 = ll[bj][1];
#pragma unroll
                for (int ai = 0; ai < 2; ++ai)
#pragma unroll
                    for (int m = 0; m < 4; ++m) { f32x4 v0 = acc[ai][bj][m][0], v1 = acc[ai][bj][m][1];
                        { const f32x4 s0 = sigmoid4(v0), s1 = sigmoid4(v1); const f32x4 f0 = __builtin_elementwise_max(l0, (f32x4){1e-30f, 1e-30f, 1e-30f, 1e-30f}) + ((f32x4){1.f, 1.f, 1.f, 1.f} - l0) * s0, f1 = __builtin_elementwise_max(l1, (f32x4){1e-30f, 1e-30f, 1e-30f, 1e-30f}) + ((f32x4){1.f, 1.f, 1.f, 1.f} - l1) * s1;
#pragma unroll
                          for (int j = 0; j < 4; ++j) { v0[j] = __logf(f0[j]); v1[j] = __logf(f1[j]); } }
                        GAS float* o = LF + (size_t)(row0 + ai * 128 + m * 16) * HW + c; *(GAS f32x4*)o = v0; *(GAS f32x4*)(o + 4) = v1; } }
        } else {
            const int kind = u.pn >> 1; GAS bf16_t* dst = kind == 0 ? U : (kind == 1 ? Q : (kind == 3 ? V : G)); const bool act = (kind == 1) || (kind == 4);
            const int c0 = (u.pn & 1) * 256 + cw;
#pragma unroll
            for (int bj = 0; bj < 2; ++bj) { const int c = c0 + bj * 128;
#pragma unroll
                for (int ai = 0; ai < 2; ++ai)
#pragma unroll
                    for (int m = 0; m < 4; ++m) { f32x4 v0 = acc[ai][bj][m][0], v1 = acc[ai][bj][m][1];
                        if (act) { v0 = silu4(v0); v1 = silu4(v1); }
                        *(GAS u32x4*)(dst + (size_t)(row0 + ai * 128 + m * 16) * PW + c) = pack8(v0, v1); } }
        }
    }
};
struct EpiGate8 {
    static constexpr int NST = 16;
    unsigned char* ws; const float* gbias; float cs;
    __device__ __forceinline__ void operator()(const AccT& acc, const pg8::Unit& u, int wr, int wc, int fr, int fq) const {
        unsigned char* wb = ws; float csl = cs; asm volatile("" : "+s"(wb), "+s"(csl));
        GAS bf16_t* const GT = (GAS bf16_t*)((GAS unsigned char*)wb + EPI_WS_GT);
        const int row0 = EPI_ROW0(u), c0 = u.pn * 256 + wc * 32 + 8 * fq;
        f32x4 bb[2][2];
#pragma unroll
        for (int bj = 0; bj < 2; ++bj) { bb[bj][0] = *(const f32x4*)(gbias + c0 + bj * 128); bb[bj][1] = *(const f32x4*)(gbias + c0 + bj * 128 + 4); }
#pragma unroll
        for (int bj = 0; bj < 2; ++bj) { const int c = c0 + bj * 128;
#pragma unroll
            for (int ai = 0; ai < 2; ++ai)
#pragma unroll
                for (int m = 0; m < 4; ++m) { f32x4 v0 = acc[ai][bj][m][0] * csl + bb[bj][0], v1 = acc[ai][bj][m][1] * csl + bb[bj][1];
                    v0 = sigmoid4(v0); v1 = sigmoid4(v1);
                    *(GAS u32x4*)(GT + (size_t)(row0 + ai * 128 + m * 16) * NGATE + c) = pack8(v0, v1); } }
    }
};
struct EpiU {
    static constexpr int NST = 16;
    unsigned char* ws;
    __device__ __forceinline__ void operator()(const AccT& acc, const pg8::Unit& u, int wr, int wc, int fr, int fq) const {
        unsigned char* wb = ws; asm volatile("" : "+s"(wb));
        GAS unsigned char* const wg = (GAS unsigned char*)wb;
        GAS bf16_t* const MG = (GAS bf16_t*)(wg + EPI_WS_H); const GAS bf16_t* const GT = (const GAS bf16_t*)(wg + EPI_WS_GT);
        const int row0 = EPI_ROW0(u), c0 = u.pn * 256 + wc * 32 + 8 * fq;
#pragma unroll
        for (int ai = 0; ai < 2; ++ai) {
            u32x4 gw[4][2], tw[4][2];
#pragma unroll
            for (int m = 0; m < 4; ++m)
#pragma unroll
                for (int bj = 0; bj < 2; ++bj) { const size_t row = (size_t)(row0 + ai * 128 + m * 16); const int c = c0 + bj * 128;
                    gw[m][bj] = *(const GAS u32x4*)(GT + row * NGATE + u.x * 1024 + c);
                    tw[m][bj] = u.x ? *(const GAS u32x4*)(MG + row * D + c) : (u32x4){0u, 0u, 0u, 0u}; }
#pragma unroll
            for (int m = 0; m < 4; ++m)
#pragma unroll
                for (int bj = 0; bj < 2; ++bj) { const size_t row = (size_t)(row0 + ai * 128 + m * 16); const int c = c0 + bj * 128; const u32x4 g = gw[m][bj], t = tw[m][bj];
                    f32x4 v0 = acc[ai][bj][m][0], v1 = acc[ai][bj][m][1];
                    v0[0] = v0[0] * bf_lo(g.x) + bf_lo(t.x); v0[1] = v0[1] * bf_hi(g.x) + bf_hi(t.x); v0[2] = v0[2] * bf_lo(g.y) + bf_lo(t.y); v0[3] = v0[3] * bf_hi(g.y) + bf_hi(t.y);
                    v1[0] = v1[0] * bf_lo(g.z) + bf_lo(t.z); v1[1] = v1[1] * bf_hi(g.z) + bf_hi(t.z); v1[2] = v1[2] * bf_lo(g.w) + bf_lo(t.w); v1[3] = v1[3] * bf_hi(g.w) + bf_hi(t.w);
                    *(GAS u32x4*)(MG + row * D + c) = pack8(v0, v1); }
        }
    }
};
struct EpiRow {
    static constexpr int NST = 16;
    bf16_t* O; int ldo; const float* rowscale; float cs;
    __device__ __forceinline__ void operator()(const AccT& acc, const pg8::Unit& u, int wr, int wc, int fr, int fq) const {
        const int row0 = EPI_ROW0(u), c0 = u.pn * 256 + wc * 32 + 8 * fq; float csl = cs; asm volatile("" : "+s"(csl));
        float sc[2][4];
#pragma unroll
        for (int ai = 0; ai < 2; ++ai)
#pragma unroll
            for (int m = 0; m < 4; ++m) sc[ai][m] = rowscale ? rowscale[row0 + ai * 128 + m * 16] * csl : csl;
#pragma unroll
        for (int ai = 0; ai < 2; ++ai)
#pragma unroll
            for (int m = 0; m < 4; ++m) { const size_t row = (size_t)(row0 + ai * 128 + m * 16); const float s = sc[ai][m];
#pragma unroll
                for (int bj = 0; bj < 2; ++bj) *(u32x4*)(O + row * ldo + c0 + bj * 128) = pack8(acc[ai][bj][m][0] * s, acc[ai][bj][m][1] * s); }
    }
};
struct EpiSwi {
    static constexpr int NST = 8;
    bf16_t* ACT; int ldact;
    __device__ __forceinline__ void operator()(const AccT& acc, const pg8::Unit& u, int wr, int wc, int fr, int fq) const {
        const int row0 = u.x * 256 + wr * 64 + fr, c0 = u.pn * 128 + wc * 32 + 8 * fq;
#pragma unroll
        for (int ai = 0; ai < 2; ++ai)
#pragma unroll
            for (int m = 0; m < 4; ++m) { f32x4 v0 = acc[ai][0][m][0], v1 = acc[ai][0][m][1]; const f32x4 u0 = acc[ai][1][m][0], u1 = acc[ai][1][m][1];
                v0 = silu4(v0) * u0; v1 = silu4(v1) * u1;
                *(u32x4*)(ACT + (size_t)(row0 + ai * 128 + m * 16) * ldact + c0) = pack8(v0, v1); }
    }
};

struct EpiSwi8 {
    static constexpr int NST = 8;
    unsigned char* ACT; int ldact; float in_scale, out_scale;
    __device__ __forceinline__ void operator()(const AccT& acc, const pg8::Unit& u, int wr, int wc, int fr, int fq) const {
        const int row0 = u.x * 256 + wr * 64 + fr, c0 = u.pn * 128 + wc * 32 + 8 * fq; const float lim = f8_limit();
        float kE_ = -in_scale * 1.44269504088896f, kU_ = in_scale * in_scale * out_scale; asm volatile("" : "+s"(kE_), "+s"(kU_));
        const f32x2 kE = {kE_, kE_}, kU = {kU_, kU_}, one = {1.0f, 1.0f};
#pragma unroll
        for (int ai = 0; ai < 2; ++ai)
#pragma unroll
            for (int m = 0; m < 4; ++m) { unsigned w[2];
#pragma unroll
                for (int n = 0; n < 2; ++n) { const f32x4 g4 = acc[ai][0][m][n], u4 = acc[ai][1][m][n]; f32x2 o[2];
#pragma unroll
                    for (int h = 0; h < 2; ++h) { const f32x2 g = {g4[2 * h], g4[2 * h + 1]}, uu = {u4[2 * h], u4[2 * h + 1]};
                        const f32x2 t = g * kE; f32x2 e; e.x = __builtin_amdgcn_exp2f(t.x); e.y = __builtin_amdgcn_exp2f(t.y);
                        const f32x2 d = e + one; f32x2 r; r.x = __builtin_amdgcn_rcpf(d.x); r.y = __builtin_amdgcn_rcpf(d.y);
                        o[h] = (g * r) * (uu * kU); }
                    w[n] = pk4_fp8(o[0].x, o[0].y, o[1].x, o[1].y, lim); }
                u32x2 ww; ww.x = w[0]; ww.y = w[1];
                *(u32x2*)(ACT + (size_t)(row0 + ai * 128 + m * 16) * ldact + c0) = ww;
                __builtin_amdgcn_sched_barrier(0); }
    }
};

struct GridOrder {
    unsigned Abase, Bbase, atile, btile; int nM, nN, G, c;
    __device__ __forceinline__ bool next(int i, pg8::Unit& u) const {
        int pm, pn; if (!pg8::grid_tile(i * G + c, nM, nN, pm, pn)) return false;
        u.pm = pm; u.pn = pn; u.x = 0; u.A = Abase + (unsigned)pm * atile; u.B = Bbase + (unsigned)pn * btile; return true; }
};
struct UOrder {
    unsigned Abase, Bbase; int G, c;
    __device__ __forceinline__ bool next(int i, pg8::Unit& u) const {
        int pm, pn; if (!pg8::grid_tile((i >> 1) * G + c, M / 256, D / 256, pm, pn)) return false;
        u.pm = pm; u.pn = pn; u.x = i & 1; u.A = Abase + (unsigned)pm * (256u * 1024 * 2) + (unsigned)(i & 1) * 1024u; u.B = Bbase + (unsigned)pn * (256u * 1024 * 2) + (unsigned)(i & 1) * 1024u; return true; }
};
struct GuOrder {
    unsigned Abase, Bbase; const int* tile_expert; unsigned bexp, tileb; int t0, nT, nN, G, c;
    __device__ __forceinline__ bool next(int i, pg8::Unit& u) const {
        int pm, pn; if (!pg8::grid_tile(i * G + c, nT, nN, pm, pn)) return false;
        const int tile = t0 + pm; const int e = tile_expert ? __builtin_amdgcn_readfirstlane(__hip_atomic_load(tile_expert + tile, __ATOMIC_RELAXED, __HIP_MEMORY_SCOPE_AGENT)) : 0;
        u.pm = tile; u.pn = pn; u.x = pm; u.A = Abase + (unsigned)tile * tileb; u.B = Bbase + (unsigned)e * bexp + (unsigned)pn * tileb; return true; }
};
struct DownOrder {
    unsigned Abase, Bbase; const int* tile_expert; unsigned bexp, atile; int t0, nT, G, c;
    __device__ __forceinline__ bool next(int i, pg8::Unit& u) const {
        int pm, pn; if (!pg8::grid_tile(i * G + c, nT, D / 256, pm, pn)) return false;
        const int tile = t0 + pm; const int e = tile_expert ? __builtin_amdgcn_readfirstlane(__hip_atomic_load(tile_expert + tile, __ATOMIC_RELAXED, __HIP_MEMORY_SCOPE_AGENT)) : 0;
        u.pm = tile; u.pn = pn; u.x = pm; u.A = Abase + (unsigned)pm * atile; u.B = Bbase + (unsigned)e * bexp + (unsigned)pn * atile; return true; }
};

constexpr size_t MiB = 1u << 20;
constexpr size_t WS_CTL = 0, CTL_BYTES = 1 * MiB;
constexpr size_t WS_SMALL = 1 * MiB;
constexpr size_t SM_LB = 0, SM_CNTWG = 4096, SM_TOKE = 16384, SM_TOKW = 147456, SM_TOKS = 409600, SM_ROWIDX = 671744, SM_ROWSC = 999424, SM_TILEEXP = 1327104, SM_NT = 1328384, SM_DT = 1536 * 1024;
constexpr int MAXT = 272, NSLOT = MAXT * 256;
static_assert(SM_ROWIDX + (size_t)NSLOT * 4 <= SM_ROWSC && SM_ROWSC + (size_t)NSLOT * 4 <= SM_TILEEXP && SM_DT + 256 * 128 * 4 <= 3 * MiB, "small map");
constexpr size_t WS_WIN = 4 * MiB, WS_WU = 22 * MiB, WS_WOUT = 26 * MiB, WS_DGU = 30 * MiB, WS_DDN = 41 * MiB;
constexpr size_t WS_H = 47 * MiB;
constexpr size_t WS_U = 111 * MiB, WS_Q = 143 * MiB, WS_LF = 175 * MiB, WS_V = 239 * MiB, WS_GG = 271 * MiB, WS_GT = 303 * MiB, WS_A2 = 431 * MiB, WS_SL = 495 * MiB, WS_SI = 511 * MiB;
constexpr size_t WS_H8 = WS_SL;
constexpr size_t WS_WG8 = 528 * MiB;
constexpr size_t WS_MO = 111 * MiB;
constexpr size_t WS_ACT0 = 111 * MiB, WS_DN0 = 287 * MiB;
constexpr size_t WS_ACT1 = 111 * MiB, WS_H2G = 237 * MiB, WS_DN1 = 305 * MiB, WS_MW = 441 * MiB;
constexpr int MOE_G0 = 128, MOE_G1 = 144, MOE_NG = 2;
constexpr size_t MW_GU_E = (size_t)2 * DFF1 * D, MW_DN_E = (size_t)D * DFF1;
constexpr size_t WS_MWD = WS_MW + NEXP * MW_GU_E;
constexpr size_t WS_END = 548 * MiB;
constexpr float F8_W = 256.0f, F8_H = 16.0f, F8_A = 8.0f;
static_assert(WS_MWD + NEXP * MW_DN_E <= WS_END && WS_H2G + (size_t)NSLOT * D <= WS_DN1 && WS_DN1 + (size_t)NSLOT * D * 2 <= WS_MW && WS_ACT1 + (size_t)MOE_G1 * 256 * DFF1 <= WS_H2G && MOE_G0 + MOE_G1 >= MAXT && WS_SI + 16 * MiB <= WS_END, "ws map");
static_assert(EPI_WS_U == WS_U && EPI_WS_Q == WS_Q && EPI_WS_LF == WS_LF && EPI_WS_V == WS_V && EPI_WS_GG == WS_GG && EPI_WS_GT == WS_GT && EPI_WS_H == WS_H && EPI_WS_LB == WS_SMALL + SM_LB, "epilogue offsets");
static_assert(WS_ACT0 + (size_t)M * DFF0 * 2 <= WS_DN0 && WS_DDN + (size_t)D * DFF0 * 2 <= WS_H, "ws map 2");
constexpr int CW_BAR = 4096;

constexpr int RING_BYTES = 131072, MISC_OFF = RING_BYTES, LDS_BYTES = 147456;
constexpr int NW = 8, NT = 512;
#define LDS_WAIT() asm volatile("s_waitcnt lgkmcnt(0)" ::: "memory")
#define LDS_BARRIER() asm volatile("s_waitcnt lgkmcnt(0)\n\ts_barrier" ::: "memory")
#define VM_WAIT() asm volatile("s_waitcnt vmcnt(0)" ::: "memory")

#define XB_TMO      128
#define XB_XCNT(j)  (256  + 64 * (j))
#define XB_XSUB(j)  (1280 + 64 * (j))
#define XB_XGEN(j)  (2304 + 64 * (j))
#define XB_TOP      3328
#define XB_TOPGEN   3392
#define XCD_BAR_WORDS 3456
#define XB_SPIN_CAP (1u << 18)
__device__ __forceinline__ unsigned xb_ld(unsigned* p)              { return __hip_atomic_load(p, __ATOMIC_RELAXED, __HIP_MEMORY_SCOPE_AGENT); }
__device__ __forceinline__ unsigned xb_add(unsigned* p, unsigned v) { return __hip_atomic_fetch_add(p, v, __ATOMIC_RELAXED, __HIP_MEMORY_SCOPE_AGENT); }
__device__ __forceinline__ unsigned xb_xcc_id() { return (unsigned)__builtin_amdgcn_s_getreg((3 << 11) | 20) & 0xFu; }
#define XB_SPIN(cond, bar) do { unsigned _sp = 0; while (cond) { __builtin_amdgcn_s_sleep(1); \
    if ((++_sp & 255u) == 0u) { if (xb_ld(&(bar)[XB_TMO])) break; if (_sp > XB_SPIN_CAP) { atomicAdd(&(bar)[XB_TMO], 1u); break; } } } } while (0)
struct XcdBarrier { unsigned* bar; unsigned x; volatile LAS unsigned* st; };
__device__ __forceinline__ XcdBarrier xcd_barrier_post(unsigned* bar, volatile LAS unsigned* st, int tid) {
    XcdBarrier b; b.bar = bar; b.x = xb_xcc_id(); b.st = st;
    if (tid == 0) (void)xb_add(&bar[XB_XCNT(b.x)], 1u);
    return b;
}
__device__ __forceinline__ void xcd_barrier_complete(unsigned* bar, unsigned x, unsigned& nloc, unsigned& nx) {
    const unsigned G = gridDim.x * gridDim.y * gridDim.z;
    unsigned sum, cnt, mine, sp = 0u;
    for (;;) {
        sum = 0u; cnt = 0u; mine = 0u;
#pragma unroll
        for (unsigned j = 0; j < 16; ++j) { const unsigned c = xb_ld(&bar[XB_XCNT(j)]); sum += c; cnt += (c > 0u) ? 1u : 0u; mine = (j == x) ? c : mine; }
        if (sum == G) break;
        __builtin_amdgcn_s_sleep(1);
        if ((++sp & 255u) == 0u) { if (xb_ld(&bar[XB_TMO])) break; if (sp > XB_SPIN_CAP) { atomicAdd(&bar[XB_TMO], 1u); break; } }
    }
    nloc = mine > 0u ? mine : 1u; nx = cnt > 0u ? cnt : 1u;
}
__device__ __forceinline__ void xcd_barrier(const XcdBarrier& b, int tid) {
    asm volatile("s_waitcnt vmcnt(0)" ::: "memory");
    __syncthreads();
    if (tid == 0) {
        unsigned* bar = b.bar;
        __builtin_amdgcn_s_waitcnt(0);
        unsigned nloc = b.st[0], nx = b.st[1];
        if (nloc == 0u) { xcd_barrier_complete(bar, b.x, nloc, nx); b.st[0] = nloc; b.st[1] = nx; }
        const unsigned old = xb_add(&bar[XB_XSUB(b.x)], 1u);
        const unsigned gen = old / nloc;
        if (old + 1u == (gen + 1u) * nloc) {
            __builtin_amdgcn_fence(__ATOMIC_RELEASE, "agent");
            asm volatile("s_waitcnt vmcnt(0)" ::: "memory");
            const unsigned og = xb_add(&bar[XB_TOP], 1u);
            const unsigned tg = og / nx;
            if (og + 1u == (tg + 1u) * nx) xb_add(&bar[XB_TOPGEN], 1u);
            else XB_SPIN(xb_ld(&bar[XB_TOPGEN]) == tg, bar);
            __builtin_amdgcn_fence(__ATOMIC_ACQUIRE, "agent");
            xb_add(&bar[XB_XGEN(b.x)], 1u);
            asm volatile("s_waitcnt vmcnt(0)" ::: "memory");
        } else {
            XB_SPIN(xb_ld(&bar[XB_XGEN(b.x)]) == gen, bar);
            __builtin_amdgcn_fence(__ATOMIC_ACQUIRE, "agent");
            asm volatile("s_waitcnt vmcnt(0)" ::: "memory");
        }
    }
    __syncthreads();
}

__device__ __forceinline__ float shfl_xor_l(float v, int o, int lane) { return __builtin_bit_cast(float, __builtin_amdgcn_ds_bpermute((lane ^ o) << 2, __builtin_bit_cast(int, v))); }
__device__ __forceinline__ float wave_sum(float v, int lane) {
#pragma unroll
    for (int o = 1; o < 64; o <<= 1) v += shfl_xor_l(v, o, lane);
    return v;
}
__device__ __forceinline__ void tr_item(const float* W, int N, int k0, int n0, bf16_t* dst, int ldd, LAS float* scr, int lane) {
    float v[32];
#pragma unroll
    for (int i = 0; i < 32; ++i) v[i] = W[(size_t)(k0 + 2 * i + (lane >> 5)) * N + n0 + (lane & 31)];
#pragma unroll
    for (int i = 0; i < 32; ++i) scr[(2 * i + (lane >> 5)) * 33 + (lane & 31)] = v[i];
    LDS_WAIT();
    const int c = lane & 7;
#pragma unroll
    for (int j = 0; j < 4; ++j) { const int n = (lane >> 3) + 8 * j; const LAS float* s = scr + (8 * c) * 33 + n;
        u32x4 o; o.x = cvt_pk_bf16(s[0 * 33], s[1 * 33]); o.y = cvt_pk_bf16(s[2 * 33], s[3 * 33]); o.z = cvt_pk_bf16(s[4 * 33], s[5 * 33]); o.w = cvt_pk_bf16(s[6 * 33], s[7 * 33]);
        *(u32x4*)(dst + (size_t)n * ldd + 8 * c) = o; }
    LDS_WAIT();
}
__device__ __forceinline__ void tr_item8(const float* W, int N, int k0, int n0, unsigned char* dst, int ldd, float scale, LAS float* scr, int lane) {
    float v[32];
#pragma unroll
    for (int i = 0; i < 32; ++i) v[i] = W[(size_t)(k0 + 2 * i + (lane >> 5)) * N + n0 + (lane & 31)];
#pragma unroll
    for (int i = 0; i < 32; ++i) scr[(2 * i + (lane >> 5)) * 33 + (lane & 31)] = v[i] * scale;
    LDS_WAIT();
    const int c = lane & 7; const float lim = f8_limit();
#pragma unroll
    for (int j = 0; j < 4; ++j) { const int n = (lane >> 3) + 8 * j; const LAS float* s = scr + (8 * c) * 33 + n;
        u32x2 o; o.x = pk4_fp8(s[0 * 33], s[1 * 33], s[2 * 33], s[3 * 33], lim); o.y = pk4_fp8(s[4 * 33], s[5 * 33], s[6 * 33], s[7 * 33], lim);
        *(u32x2*)(dst + (size_t)n * ldd + 8 * c) = o; }
    LDS_WAIT();
}
__device__ __forceinline__ void tr_plain(const float* W, int K, int N, bf16_t* WT, int ldd, int kcol0, int it, LAS float* scr, int lane) {
    const int nblk = N / 32, kb = it / nblk, nb = it % nblk;
    tr_item(W, N, 64 * kb, 32 * nb, WT + (size_t)(32 * nb) * ldd + kcol0 + 64 * kb, ldd, scr, lane);
}
__device__ __forceinline__ void tr_gu(const float* W, int dff, int isup, bf16_t* WT, int it, LAS float* scr, int lane) {
    const int nblk = dff / 32, kb = it / nblk, nb = it % nblk, n0 = 32 * nb, drow = 256 * (n0 >> 7) + 128 * isup + (n0 & 127);
    tr_item(W, dff, 64 * kb, n0, WT + (size_t)drow * D + 64 * kb, D, scr, lane);
}

struct Args { const float* in[20]; float* out; unsigned char* ws; int lo, hi; };
#define CAS __attribute__((address_space(4)))
struct Ctx {
    LAS unsigned char* lds; int tid, lane, wave, G, bid;
    const CAS Args* a;
};
#define CIN(i) (C.a->in[i])
#define C_WS (C.a->ws)
#define C_OUT (C.a->out)
#define C_G (C.G)
#define C_BID (C.bid)
#define WSP(T, off) ((T*)(C_WS + (off)))
#define SMP(T, off) ((T*)(C_WS + WS_SMALL + (off)))

__device__ __forceinline__ void phase_prologue(Ctx& C) {
    LAS float* scr = (LAS float*)(C.lds + C.wave * 16384);
    const int gw = C_BID * NW + C.wave, NGW = C_G * NW;
    constexpr int I_IN = (D / 64) * ((INC - NGATE) / 32), I_HU = (HW / 64) * (D / 32), I_WO = (D / 64) * (D / 32), I_GU = (D / 64) * (DFF0 / 32), I_DN = (DFF0 / 64) * (D / 32);
    constexpr int I_G8 = (D / 64) * (NGATE / 32);
    constexpr int NITEMS = 2 * (I_IN + I_HU + I_WO) + 2 * I_GU + I_DN + 2 * I_G8;
    for (int it = gw; it < NITEMS; it += NGW) {
        int r = it;
        if (r < 2 * I_IN) { const int l = r / I_IN, q = r % I_IN, nblk = (INC - NGATE) / 32, kb = q / nblk, nb = q % nblk;
            tr_item(CIN(2) + (size_t)l * D * INC, INC, 64 * kb, 32 * nb, WSP(bf16_t, WS_WIN) + (size_t)l * INC * D + (size_t)(32 * nb) * D + 64 * kb, D, scr, C.lane); continue; } r -= 2 * I_IN;
        if (r < 2 * I_HU) { const int l = r / I_HU; tr_plain(CIN(9) + (size_t)l * HW * D, HW, D, WSP(bf16_t, WS_WU) + (size_t)l * D * D, D, 512, r % I_HU, scr, C.lane); continue; } r -= 2 * I_HU;
        if (r < 2 * I_WO) { const int l = r / I_WO; tr_plain(CIN(10) + (size_t)l * D * D, D, D, WSP(bf16_t, WS_WOUT) + (size_t)l * D * D, D, 0, r % I_WO, scr, C.lane); continue; } r -= 2 * I_WO;
        if (r < I_GU) { tr_gu(CIN(12), DFF0, 0, WSP(bf16_t, WS_DGU), r, scr, C.lane); continue; } r -= I_GU;
        if (r < I_GU) { tr_gu(CIN(13), DFF0, 1, WSP(bf16_t, WS_DGU), r, scr, C.lane); continue; } r -= I_GU;
        if (r < I_DN) { tr_plain(CIN(14), DFF0, D, WSP(bf16_t, WS_DDN), DFF0, 0, r, scr, C.lane); continue; } r -= I_DN;
        { const int l = r / I_G8, q = r % I_G8, nblk = NGATE / 32, kb = q / nblk, nb = q % nblk;
          tr_item8(CIN(2) + (size_t)l * D * INC, INC, 64 * kb, (INC - NGATE) + 32 * nb, C_WS + WS_WG8 + (size_t)l * NGATE * D + (size_t)(32 * nb) * D + 64 * kb, D, F8_W, scr, C.lane); }
    }
    for (int it = gw; it < 2 * 4 * 16 * 16; it += NGW) {
        const int nb = it & 15, kb = (it >> 4) & 15, g = (it >> 8) & 3, l = it >> 10;
        const float* pw = CIN(4) + ((size_t)l * PW + g * 128 + kb * 8) * 128; const float* ps = CIN(5) + l * PW + g * 128; const float* pu = CIN(6) + ((size_t)l * PW + g * 128) * D + nb * 64 + C.lane;
        float acc8[8];
#pragma unroll
        for (int j = 0; j < 8; ++j) acc8[j] = 0.f;
#pragma unroll 8
        for (int d = 0; d < 128; ++d) { const float x = ps[d] * pu[(size_t)d * D];
#pragma unroll
            for (int j = 0; j < 8; ++j) acc8[j] += pw[j * 128 + d] * x; }
        u32x4 o; o.x = cvt_pk_bf16(acc8[0], acc8[1]); o.y = cvt_pk_bf16(acc8[2], acc8[3]); o.z = cvt_pk_bf16(acc8[4], acc8[5]); o.w = cvt_pk_bf16(acc8[6], acc8[7]);
        *(u32x4*)(WSP(bf16_t, WS_WU) + (size_t)l * D * D + (size_t)(nb * 64 + C.lane) * D + g * 128 + kb * 8) = o;
    }
    if (C_BID == 0) { float* lbv = SMP(float, SM_LB);
        for (int c = C.tid; c < HW; c += NT) { const float b0 = CIN(7)[c], b1 = CIN(7)[HW + c], mx = fmaxf(b0, b1), e0 = expf(b0 - mx), e1 = expf(b1 - mx), s0 = e0 / (e0 + e1), s1 = e1 / (e0 + e1);
            lbv[c] = 0.f; lbv[HW + c] = fminf(fmaxf((s0 + s1) - s0, 0.f), 1.0f - 1e-6f); } }
}
__device__ __forceinline__ void phase_moe_weights(Ctx& C) {
    LAS float* scr = (LAS float*)(C.lds + C.wave * 16384);
    const int gw = C_BID * NW + C.wave, NGW = C_G * NW;
    constexpr int I_GU = (D / 64) * (DFF1 / 32), I_DN = (DFF1 / 64) * (D / 32);
    for (int it = gw; it < NEXP * (2 * I_GU + I_DN); it += NGW) {
        const int e = it / (2 * I_GU + I_DN); int r = it % (2 * I_GU + I_DN);
        if (r < 2 * I_GU) { const int isup = r >= I_GU ? 1 : 0; r -= isup * I_GU; const int nblk = DFF1 / 32, kb = r / nblk, nb = r % nblk, n0 = 32 * nb, drow = 256 * (n0 >> 7) + 128 * isup + (n0 & 127);
            tr_item8(CIN(16 + isup) + (size_t)e * D * DFF1, DFF1, 64 * kb, n0, C_WS + WS_MW + e * MW_GU_E + (size_t)drow * D + 64 * kb, D, F8_W, scr, C.lane); continue; }
        r -= 2 * I_GU;
        { const int nblk = D / 32, kb = r / nblk, nb = r % nblk;
          tr_item8(CIN(18) + (size_t)e * DFF1 * D, D, 64 * kb, 32 * nb, C_WS + WS_MWD + e * MW_DN_E + (size_t)(32 * nb) * DFF1 + 64 * kb, DFF1, F8_W, scr, C.lane); }
    }
}

__device__ __forceinline__ void phase_norm(Ctx& C, const float* xsrc, float* xdst, const float* w, bf16_t* hout, float* fout,
                                           const bf16_t* add, const int* slots, int nadd, const float* router, unsigned char* h8out = nullptr) {
    LAS float* RL = (LAS float*)C.lds;
    LAS int* cnt8 = (LAS int*)(C.lds + 32768);
    if (router) { for (int i = C.tid; i < D * NEXP / 4; i += NT) { const int c = i >> 1; ((LAS f32x4*)RL)[(i & 1) * 1024 + (4 * (c >> 8) + (c & 3)) * 64 + ((c & 255) >> 2)] = ((const f32x4*)router)[i]; } if (C.tid < 8) cnt8[C.tid] = 0; __syncthreads(); }
    float eps_ = EPS; asm volatile("" : "+s"(eps_));
    f32x4 wv[4];
#pragma unroll
    for (int j = 0; j < 4; ++j) wv[j] = ((const f32x4*)w)[64 * j + C.lane];
    for (int i = 0; i < 16; ++i) {
        const int row = C_BID * 128 + C.wave * 16 + i;
        const f32x4* xr = (const f32x4*)(xsrc + (size_t)row * D) + C.lane;
        f32x4 v[4];
#pragma unroll
        for (int j = 0; j < 4; ++j) v[j] = xr[64 * j];
        for (int a = 0; a < nadd; ++a) { const int ar = slots ? slots[2 * row + a] : row; const u32x2* p = (const u32x2*)(add + (size_t)ar * D) + C.lane;
#pragma unroll
            for (int j = 0; j < 4; ++j) { const u32x2 t = p[64 * j]; v[j][0] += bf_lo(t.x); v[j][1] += bf_hi(t.x); v[j][2] += bf_lo(t.y); v[j][3] += bf_hi(t.y); } }
        float ss = 0.f;
#pragma unroll
        for (int j = 0; j < 4; ++j) ss += (v[j][0] * v[j][0] + v[j][1] * v[j][1]) + (v[j][2] * v[j][2] + v[j][3] * v[j][3]);
        const float rs = 1.0f / sqrtf(wave_sum(ss, C.lane) * (1.0f / D) + eps_);
        if (xdst) { f32x4* xo = (f32x4*)(xdst + (size_t)row * D) + C.lane;
#pragma unroll
            for (int j = 0; j < 4; ++j) xo[64 * j] = v[j]; }
#pragma unroll
        for (int j = 0; j < 4; ++j) v[j] = v[j] * rs * wv[j];
        if (hout) { u32x2* ho = (u32x2*)(hout + (size_t)row * D) + C.lane;
#pragma unroll
            for (int j = 0; j < 4; ++j) { u32x2 t; t.x = cvt_pk_bf16(v[j][0], v[j][1]); t.y = cvt_pk_bf16(v[j][2], v[j][3]); ho[64 * j] = t; } }
        if (h8out) { const float lim = f8_limit(); unsigned* h8 = (unsigned*)(h8out + (size_t)row * D) + C.lane;
#pragma unroll
            for (int j = 0; j < 4; ++j) h8[64 * j] = pk4_fp8(v[j][0] * F8_H, v[j][1] * F8_H, v[j][2] * F8_H, v[j][3] * F8_H, lim); }
        if (fout) { f32x4* fo = (f32x4*)(fout + (size_t)row * D) + C.lane;
#pragma unroll
            for (int j = 0; j < 4; ++j) fo[64 * j] = v[j]; }
        if (router) {
            float lg[8];
#pragma unroll
            for (int e = 0; e < 8; ++e) lg[e] = 0.f;
#pragma unroll
            for (int j = 0; j < 4; ++j)
#pragma unroll
                for (int q = 0; q < 4; ++q) { const LAS f32x4* rp = (const LAS f32x4*)RL + (4 * j + q) * 64 + C.lane; const f32x4 r0 = rp[0], r1 = rp[1024]; const float hv = v[j][q];
                    lg[0] += hv * r0[0]; lg[1] += hv * r0[1]; lg[2] += hv * r0[2]; lg[3] += hv * r0[3]; lg[4] += hv * r1[0]; lg[5] += hv * r1[1]; lg[6] += hv * r1[2]; lg[7] += hv * r1[3]; }
#pragma unroll
            for (int e = 0; e < 8; ++e) lg[e] = wave_sum(lg[e], C.lane);
            int e1 = 0; float v1 = lg[0];
#pragma unroll
            for (int e = 1; e < 8; ++e) if (lg[e] > v1) { v1 = lg[e]; e1 = e; }
            int e2 = -1; float v2 = -3.0e38f;
#pragma unroll
            for (int e = 0; e < 8; ++e) if (e != e1 && lg[e] > v2) { v2 = lg[e]; e2 = e; }
            const float ex = expf(v2 - v1), w1 = 1.0f / (1.0f + ex), w2 = ex / (1.0f + ex);
            if (C.lane == 0) { SMP(int, SM_TOKE)[row] = e1 | (e2 << 8); SMP(f32x2, SM_TOKW)[row] = (f32x2){w1, w2}; atomicAdd((int*)cnt8 + e1, 1); atomicAdd((int*)cnt8 + e2, 1); }
        }
    }
    if (router) { __syncthreads(); if (C.tid < 8) SMP(int, SM_CNTWG)[C_BID * 8 + C.tid] = cnt8[C.tid]; }
}

constexpr int TAILSLOT = 256 * 256;
__device__ __forceinline__ void phase_norm_router(Ctx& C, float* x, const float* w, const bf16_t* add, unsigned char* h8out, const float* router) {
    LAS float* RL = (LAS float*)C.lds;
    LAS int* cnt8 = (LAS int*)(C.lds + 32768);
    for (int i = C.tid; i < D * NEXP / 4; i += NT) { const int c = i >> 1; ((LAS f32x4*)RL)[(i & 1) * 1024 + (4 * (c >> 8) + (c & 3)) * 64 + ((c & 255) >> 2)] = ((const f32x4*)router)[i]; }
    if (C.tid < 8) cnt8[C.tid] = 0;
    __syncthreads();
    float eps_ = EPS; asm volatile("" : "+s"(eps_));
    f32x4 wv[4];
#pragma unroll
    for (int j = 0; j < 4; ++j) wv[j] = ((const f32x4*)w)[64 * j + C.lane];
    const int row0 = C_BID * 128 + C.wave * 16;
    const bool b0 = C.lane & 1, b1 = C.lane & 2, b2 = C.lane & 4;
    f32x4 xv[4]; u32x2 av[4];
    { const f32x4* xr = (const f32x4*)(x + (size_t)row0 * D) + C.lane; const u32x2* p = (const u32x2*)(add + (size_t)row0 * D) + C.lane;
#pragma unroll
      for (int j = 0; j < 4; ++j) { xv[j] = xr[64 * j]; av[j] = p[64 * j]; } }
    for (int i = 0; i < 16; ++i) {
        const int row = row0 + i;
        f32x4 v[4];
#pragma unroll
        for (int j = 0; j < 4; ++j) { v[j] = xv[j]; v[j][0] += bf_lo(av[j].x); v[j][1] += bf_hi(av[j].x); v[j][2] += bf_lo(av[j].y); v[j][3] += bf_hi(av[j].y); }
        { const int nrow = row0 + min(i + 1, 15); const f32x4* xr = (const f32x4*)(x + (size_t)nrow * D) + C.lane; const u32x2* p = (const u32x2*)(add + (size_t)nrow * D) + C.lane;
#pragma unroll
          for (int j = 0; j < 4; ++j) { xv[j] = xr[64 * j]; av[j] = p[64 * j]; } }
        float ss = 0.f;
#pragma unroll
        for (int j = 0; j < 4; ++j) ss += (v[j][0] * v[j][0] + v[j][1] * v[j][1]) + (v[j][2] * v[j][2] + v[j][3] * v[j][3]);
        const float rs = 1.0f / sqrtf(wave_sum(ss, C.lane) * (1.0f / D) + eps_);
        { f32x4* xo = (f32x4*)(x + (size_t)row * D) + C.lane;
#pragma unroll
          for (int j = 0; j < 4; ++j) xo[64 * j] = v[j]; }
#pragma unroll
        for (int j = 0; j < 4; ++j) v[j] = v[j] * rs * wv[j];
        { const float lim = f8_limit(); unsigned* h8 = (unsigned*)(h8out + (size_t)row * D) + C.lane;
#pragma unroll
          for (int j = 0; j < 4; ++j) h8[64 * j] = pk4_fp8(v[j][0] * F8_H, v[j][1] * F8_H, v[j][2] * F8_H, v[j][3] * F8_H, lim); }
        f32x2 lg[4];
#pragma unroll
        for (int e = 0; e < 4; ++e) lg[e] = (f32x2){0.f, 0.f};
#pragma unroll
        for (int j = 0; j < 4; ++j)
#pragma unroll
            for (int q = 0; q < 4; ++q) { const LAS f32x4* rp = (const LAS f32x4*)RL + (4 * j + q) * 64 + C.lane; const f32x4 r0 = rp[0], r1 = rp[1024]; const f32x2 hv = (f32x2){v[j][q], v[j][q]};
                lg[0] = __builtin_elementwise_fma(hv, (f32x2){r0[0], r0[1]}, lg[0]); lg[1] = __builtin_elementwise_fma(hv, (f32x2){r0[2], r0[3]}, lg[1]);
                lg[2] = __builtin_elementwise_fma(hv, (f32x2){r1[0], r1[1]}, lg[2]); lg[3] = __builtin_elementwise_fma(hv, (f32x2){r1[2], r1[3]}, lg[3]); }
        float t4[4], t2[2], t1;
        { const float a[8] = {lg[0][0], lg[0][1], lg[1][0], lg[1][1], lg[2][0], lg[2][1], lg[3][0], lg[3][1]};
#pragma unroll
          for (int k = 0; k < 4; ++k) { const float send = b0 ? a[k] : a[k + 4], keep = b0 ? a[k + 4] : a[k]; t4[k] = keep + shfl_xor_l(send, 1, C.lane); } }
#pragma unroll
        for (int k = 0; k < 2; ++k) { const float send = b1 ? t4[k] : t4[k + 2], keep = b1 ? t4[k + 2] : t4[k]; t2[k] = keep + shfl_xor_l(send, 2, C.lane); }
        { const float send = b2 ? t2[0] : t2[1], keep = b2 ? t2[1] : t2[0]; t1 = keep + shfl_xor_l(send, 4, C.lane); }
        t1 += shfl_xor_l(t1, 8, C.lane); t1 += shfl_xor_l(t1, 16, C.lane); t1 += shfl_xor_l(t1, 32, C.lane);
        float lt[8];
#pragma unroll
        for (int e = 0; e < 8; ++e) lt[e] = __builtin_bit_cast(float, __builtin_amdgcn_readlane(__builtin_bit_cast(int, t1), ((e >> 2) & 1) | (((e >> 1) & 1) << 1) | ((e & 1) << 2)));
        int e1 = 0; float v1 = lt[0];
#pragma unroll
        for (int e = 1; e < 8; ++e) if (lt[e] > v1) { v1 = lt[e]; e1 = e; }
        int e2 = -1; float v2 = -3.0e38f;
#pragma unroll
        for (int e = 0; e < 8; ++e) if (e != e1 && lt[e] > v2) { v2 = lt[e]; e2 = e; }
        const float ex = expf(v2 - v1), w1 = 1.0f / (1.0f + ex), w2 = ex / (1.0f + ex);
        if (C.lane == 0) { SMP(int, SM_TOKE)[row] = e1 | (e2 << 8); SMP(f32x2, SM_TOKW)[row] = (f32x2){w1, w2}; atomicAdd((int*)cnt8 + e1, 1); atomicAdd((int*)cnt8 + e2, 1); }
    }
    __syncthreads();
    if (C.tid < 8) SMP(int, SM_CNTWG)[C_BID * 8 + C.tid] = cnt8[C.tid];
}
__device__ __forceinline__ void phase_final(Ctx& C, int mode, int nskip) {
    const int vb = C_BID - nskip, nwk = C_G - nskip; if (vb < 0) return;
    const float* w = CIN(19); float* xo = C_OUT; const bf16_t* dn = WSP(bf16_t, WS_DN1); const int* slots = SMP(int, SM_TOKS);
    float eps_ = EPS; asm volatile("" : "+s"(eps_));
    f32x4 wv[4];
#pragma unroll
    for (int j = 0; j < 4; ++j) wv[j] = ((const f32x4*)w)[64 * j + C.lane];
    for (int row = vb * NW + C.wave; row < M; row += nwk * NW) {
        const int s1 = slots[2 * row], s2 = slots[2 * row + 1];
        const bool tail = (s1 >= TAILSLOT) || (s2 >= TAILSLOT);
        if ((mode == 1) == tail) continue;
        f32x4* xr = (f32x4*)(xo + (size_t)row * D) + C.lane; const u32x2* p1 = (const u32x2*)(dn + (size_t)s1 * D) + C.lane; const u32x2* p2_ = (const u32x2*)(dn + (size_t)s2 * D) + C.lane;
        f32x4 v[4]; u32x2 a[4], b[4];
#pragma unroll
        for (int j = 0; j < 4; ++j) { v[j] = xr[64 * j]; a[j] = p1[64 * j]; b[j] = p2_[64 * j]; }
        float ss = 0.f;
#pragma unroll
        for (int j = 0; j < 4; ++j) { v[j][0] += bf_lo(a[j].x) + bf_lo(b[j].x); v[j][1] += bf_hi(a[j].x) + bf_hi(b[j].x); v[j][2] += bf_lo(a[j].y) + bf_lo(b[j].y); v[j][3] += bf_hi(a[j].y) + bf_hi(b[j].y);
            ss += (v[j][0] * v[j][0] + v[j][1] * v[j][1]) + (v[j][2] * v[j][2] + v[j][3] * v[j][3]); }
        const float rs = 1.0f / sqrtf(wave_sum(ss, C.lane) * (1.0f / D) + eps_);
#pragma unroll
        for (int j = 0; j < 4; ++j) xr[64 * j] = v[j] * rs * wv[j];
    }
}
__device__ __forceinline__ void phase_route(Ctx& C) {
    LAS int* tot = (LAS int*)C.lds; LAS int* bef = tot + 8; LAS int* base = tot + 16;
    const int* cw = SMP(int, SM_CNTWG);
    { LAS int* pt = tot + 32; LAS int* pb = pt + 512; const int e = C.tid & 7, part = C.tid >> 3; int t = 0, b = 0;
#pragma unroll
      for (int q = 0; q < 4; ++q) { const int g = part * 4 + q; const int c = (g < C_G) ? cw[g * 8 + e] : 0; t += c; b += (g < C_BID) ? c : 0; }
      pt[C.tid] = t; pb[C.tid] = b; }
    __syncthreads();
    if (C.tid < 8) { LAS int* pt = tot + 32; LAS int* pb = pt + 512; int t = 0, b = 0;
#pragma unroll 8
        for (int p = 0; p < 64; ++p) { t += pt[p * 8 + C.tid]; b += pb[p * 8 + C.tid]; }
        tot[C.tid] = t; bef[C.tid] = b; }
    __syncthreads();
    if (C.tid == 0) { int s = 0; for (int e = 0; e < 8; ++e) { base[e] = s; s += ((tot[e] + 255) >> 8) << 8; } base[8] = s; }
    __syncthreads();
    int* rowidx = SMP(int, SM_ROWIDX); float* rowsc = SMP(float, SM_ROWSC);
    if (C_BID == 0) { const int ntiles = base[8] >> 8;
        for (int t = C.tid; t < MAXT; t += NT) { int e = 0; for (int q = 1; q < 8; ++q) e += (base[q] <= t * 256) ? 1 : 0; SMP(int, SM_TILEEXP)[t] = (t < ntiles) ? e : 0; }
        if (C.tid == 0) SMP(int, SM_NT)[0] = ntiles; }
    if (C_BID < 8) { const int e = C_BID; for (int s = base[e] + tot[e] + C.tid; s < base[e + 1]; s += NT) { rowidx[s] = 0; rowsc[s] = 0.f; } }
    if (C.wave == 0) {
        int run[8];
#pragma unroll
        for (int e = 0; e < 8; ++e) run[e] = base[e] + bef[e];
        for (int p = 0; p < 2; ++p) {
            const int tok = C_BID * 128 + p * 64 + C.lane; const int ee = SMP(int, SM_TOKE)[tok], e1 = ee & 255, e2 = ee >> 8; const f32x2 tw = SMP(f32x2, SM_TOKW)[tok];
            int s1 = 0, s2 = 0; const unsigned long long below = (1ull << C.lane) - 1ull;
#pragma unroll
            for (int e = 0; e < 8; ++e) { const bool has = (e1 == e) || (e2 == e); const unsigned long long m = __ballot(has); const int pos = run[e] + __popcll(m & below);
                if (e1 == e) s1 = pos; if (e2 == e) s2 = pos; run[e] += __popcll(m); }
            rowidx[s1] = tok; rowsc[s1] = tw.x; rowidx[s2] = tok; rowsc[s2] = tw.y; SMP(int, SM_TOKS)[2 * tok] = s1; SMP(int, SM_TOKS)[2 * tok + 1] = s2;
        }
    }
}
__device__ __forceinline__ void phase_gather(Ctx& C) {
    const int nslots = __hip_atomic_load(SMP(int, SM_NT), __ATOMIC_RELAXED, __HIP_MEMORY_SCOPE_AGENT) * 256; const int* rowidx = SMP(int, SM_ROWIDX);
    for (int s = C_BID * NW + C.wave; s < nslots; s += C_G * NW * 2) {
        const int s2 = s + C_G * NW; const bool has2 = s2 < nslots;
        const u32x4 a = *((const u32x4*)(C_WS + WS_H + (size_t)rowidx[s] * D) + C.lane);
        u32x4 b = a; if (has2) b = *((const u32x4*)(C_WS + WS_H + (size_t)rowidx[s2] * D) + C.lane);
        *((u32x4*)(C_WS + WS_H2G + (size_t)s * D) + C.lane) = a;
        if (has2) *((u32x4*)(C_WS + WS_H2G + (size_t)s2 * D) + C.lane) = b; }
}
__device__ __forceinline__ void phase_pool(Ctx& C) {
    const bf16_t* U = WSP(bf16_t, WS_U); bf16_t* A2 = WSP(bf16_t, WS_A2);
    const int win = 2 << (C.lane >> 4);
    for (int run = C_BID * NW + C.wave; run < M / 16; run += C_G * NW) {
        const int t0 = run * 16, p0 = t0 & (SEQ - 1);
        u32x4 cu[16], ou[16];
#pragma unroll
        for (int tt = 0; tt < 16; ++tt) cu[tt] = *((const u32x4*)(U + (size_t)(t0 + tt) * PW) + C.lane);
#pragma unroll
        for (int tt = 0; tt < 16; ++tt) { ou[tt] = (u32x4){0u, 0u, 0u, 0u}; if (p0 + tt - win + 1 >= 0) ou[tt] = *((const u32x4*)(U + (size_t)(t0 + tt - win + 1) * PW) + C.lane); }
        float s[8];
#pragma unroll
        for (int q = 0; q < 8; ++q) s[q] = 0.f;
        for (int h = 1; h < 16; ++h) if (h < win && p0 - h >= 0) { const u32x4 t = *((const u32x4*)(U + (size_t)(t0 - h) * PW) + C.lane);
            s[0] += bf_lo(t.x); s[1] += bf_hi(t.x); s[2] += bf_lo(t.y); s[3] += bf_hi(t.y); s[4] += bf_lo(t.z); s[5] += bf_hi(t.z); s[6] += bf_lo(t.w); s[7] += bf_hi(t.w); }
#pragma unroll
        for (int tt = 0; tt < 16; ++tt) {
            const int t = t0 + tt, p = p0 + tt; const u32x4 c4 = cu[tt], o = ou[tt];
            const float c[8] = {bf_lo(c4.x), bf_hi(c4.x), bf_lo(c4.y), bf_hi(c4.y), bf_lo(c4.z), bf_hi(c4.z), bf_lo(c4.w), bf_hi(c4.w)};
#pragma unroll
            for (int q = 0; q < 8; ++q) s[q] += c[q];
            const float inv = 1.0f / (float)((p + 1) < win ? (p + 1) : win);
            u32x4 r; r.x = cvt_pk_bf16(s[0] * inv - c[0], s[1] * inv - c[1]); r.y = cvt_pk_bf16(s[2] * inv - c[2], s[3] * inv - c[3]);
            r.z = cvt_pk_bf16(s[4] * inv - c[4], s[5] * inv - c[5]); r.w = cvt_pk_bf16(s[6] * inv - c[6], s[7] * inv - c[7]);
            *((u32x4*)(A2 + (size_t)t * D) + C.lane) = r;
            s[0] -= bf_lo(o.x); s[1] -= bf_hi(o.x); s[2] -= bf_lo(o.y); s[3] -= bf_hi(o.y); s[4] -= bf_lo(o.z); s[5] -= bf_hi(o.z); s[6] -= bf_lo(o.w); s[7] -= bf_hi(o.w);
        }
    }
}

constexpr int HQ_QT = 0, HQ_KH = 17408, HQ_KT = 34816, HQ_VT = 53248, HQ_ST = 71680, HQ_PP = 106496, HQ_DC = 117760, HQ_ER = 118272, HQ_NS = 118784, HQ_TS = 119296;
constexpr int HQ_OT = 0, OTP = 528;
static_assert(64 * OTP <= HQ_KT, "output staging fits over QT | KH");
constexpr int LD128 = 272, LD64 = 144;
template <bool OUT>
__device__ __forceinline__ void hgrn_item(Ctx& C, int item, const float* nw  ) {
    const int bh = item >> 5, j = item & 31, hh = bh & 3, row0 = (bh >> 2) * SEQ + j * 512;
    const int tid = C.tid, lane = C.lane, w = C.wave, fr = lane & 15, fq = lane >> 4;
    LAS unsigned char* L = C.lds;
    const f32x2* LFp = (const f32x2*)(WSP(float, WS_LF) + hh * 128) + lane; const unsigned* Qp = (const unsigned*)(WSP(bf16_t, WS_Q) + hh * 128) + lane; const unsigned* Vp = (const unsigned*)(WSP(bf16_t, WS_V) + hh * 128) + lane;
    f32x4 acc[8];
    if (OUT) { const float* si = WSP(float, WS_SI) + (size_t)item * 16384;
#pragma unroll
        for (int vj = 0; vj < 8; ++vj)
#pragma unroll
            for (int r = 0; r < 4; ++r) acc[vj][r] = si[(16 * w + 4 * fq + r) * 128 + 16 * vj + fr];
    } else {
#pragma unroll
        for (int vj = 0; vj < 8; ++vj) acc[vj] = (f32x4){0.f, 0.f, 0.f, 0.f};
    }
    f32x2 gtot = (f32x2){0.f, 0.f}; float lim80 = 80.f, eps_ = EPS; asm volatile("" : "+s"(lim80), "+s"(eps_));
    f32x2 lfA[8], lfB[8]; unsigned vvA[8], vvB[8], qvA[8], qvB[8];
#define HG_ISSUE(LF_, VV_, QV_, cc) do { const int rbn_ = row0 + (cc) * 64 + 8 * w; _Pragma("unroll") for (int t = 0; t < 8; ++t) { LF_[t] = LFp[(size_t)(rbn_ + t) * (HW / 2)]; VV_[t] = Vp[(size_t)(rbn_ + t) * (HW / 2)]; if (OUT) QV_[t] = Qp[(size_t)(rbn_ + t) * (HW / 2)]; } } while (0)
    HG_ISSUE(lfA, vvA, qvA, 0);
    auto chunk = [&](f32x2 (&lf)[8], unsigned (&vv)[8], unsigned (&qv)[8], f32x2 (&lfn)[8], unsigned (&vvn)[8], unsigned (&qvn)[8], const int c) __attribute__((always_inline)) {
        const int m0 = row0 + c * 64;
        if (!OUT) { if (c < 7) HG_ISSUE(lfn, vvn, qvn, c + 1); }
        f32x2 Lc[8]; { f32x2 run = (f32x2){0.f, 0.f};
#pragma unroll
            for (int t = 0; t < 8; ++t) { run += lf[t]; Lc[t] = run; } }
        ((LAS f32x2*)(L + HQ_TS))[w * 64 + lane] = Lc[7];
        LDS_BARRIER();
        f32x2 P2 = (f32x2){0.f, 0.f}, P4 = (f32x2){0.f, 0.f}, Pi = (f32x2){0.f, 0.f};
#pragma unroll
        for (int s = 0; s < 8; ++s) { const f32x2 ts = ((LAS f32x2*)(L + HQ_TS))[s * 64 + lane]; P4 += ts; if (s < 4) P2 += ts; if (s < w) Pi += ts; }
        if (w == 0) { ((LAS f32x2*)(L + HQ_DC))[lane] = (f32x2){fast_exp(P4[0]), fast_exp(P4[1])}; ((LAS f32x2*)(L + HQ_ER))[lane] = (f32x2){fast_exp(P2[0]), fast_exp(P2[1])}; gtot += P4; }
        float kt[2][8];
#pragma unroll
        for (int t = 0; t < 8; ++t) {
            float qt2[2], kh2[2];
#pragma unroll
            for (int h = 0; h < 2; ++h) { const float Gt = Pi[h] + Lc[t][h]; const float kk = 1.0f - fast_exp(lf[t][h]);
                const float a = __builtin_amdgcn_fmed3f(Gt - P2[h], -lim80, lim80);
                if (OUT) { const float qf = h ? bf_hi(qv[t]) : bf_lo(qv[t]); qt2[h] = qf * fast_exp(a); kh2[h] = kk * fast_exp(-a); }
                kt[h][t] = kk * fast_exp(P4[h] - Gt); }
            if (OUT) { const int trow = 8 * w + t;
                *(LAS unsigned*)(L + HQ_QT + trow * LD128 + lane * 4) = cvt_pk_bf16(qt2[0], qt2[1]);
                *(LAS unsigned*)(L + HQ_KH + trow * LD128 + lane * 4) = cvt_pk_bf16(kh2[0], kh2[1]); }
        }
#pragma unroll
        for (int h = 0; h < 2; ++h) {
            *(LAS u32x4*)(L + HQ_KT + (2 * lane + h) * LD64 + w * 16) = (u32x4){cvt_pk_bf16(kt[h][0], kt[h][1]), cvt_pk_bf16(kt[h][2], kt[h][3]), cvt_pk_bf16(kt[h][4], kt[h][5]), cvt_pk_bf16(kt[h][6], kt[h][7])};
            u32x4 vo;
#pragma unroll
            for (int t2 = 0; t2 < 4; ++t2) vo[t2] = h ? ((vv[2 * t2] >> 16) | (vv[2 * t2 + 1] & 0xffff0000u)) : ((vv[2 * t2] & 0xffffu) | (vv[2 * t2 + 1] << 16));
            *(LAS u32x4*)(L + HQ_VT + (2 * lane + h) * LD64 + w * 16) = vo; }
        LDS_BARRIER();
        bf16x8 aq[4]; u32x4 gw0, gw1; f32x4 nv[4];
        const int ti = w >> 1;
        if (OUT) {
            const f32x4 er = *(const LAS f32x4*)(L + HQ_ER + (16 * w + 4 * fq) * 4);
#pragma unroll
            for (int vj = 0; vj < 8; ++vj) { u32x2 p; p.x = cvt_pk_bf16(acc[vj][0] * er[0], acc[vj][1] * er[1]); p.y = cvt_pk_bf16(acc[vj][2] * er[2], acc[vj][3] * er[3]);
                *(LAS u32x2*)(L + HQ_ST + (16 * vj + fr) * LD128 + (16 * w + 4 * fq) * 2) = p; }
#pragma unroll
            for (int k2 = 0; k2 < 4; ++k2) aq[k2] = *(const LAS bf16x8*)(L + HQ_QT + (16 * ti + fr) * LD128 + (32 * k2 + 8 * fq) * 2);
#pragma unroll
            for (int q = 0; q < 2; ++q) { const int tj = 2 * (w & 1) + q; f32x4 sc = (f32x4){0.f, 0.f, 0.f, 0.f};
#pragma unroll
                for (int k2 = 0; k2 < 4; ++k2) { const bf16x8 bk = *(const LAS bf16x8*)(L + HQ_KH + (16 * tj + fr) * LD128 + (32 * k2 + 8 * fq) * 2); sc = __builtin_amdgcn_mfma_f32_16x16x32_bf16(aq[k2], bk, sc, 0, 0, 0); }
#pragma unroll
                for (int r = 0; r < 4; ++r) { const int t = 16 * ti + 4 * fq + r, s = 16 * tj + fr; const float pv = (s <= t) ? sc[r] : 0.f;
                    *(LAS bf16_t*)(L + HQ_PP + t * LD64 + s * 2) = (bf16_t)(cvt_pk_bf16(pv, 0.f) & 0xffffu); } }
            { const bf16_t* gp = WSP(bf16_t, WS_GG) + (size_t)(m0 + (tid >> 3)) * HW + hh * 128 + 16 * (tid & 7); gw0 = *(const u32x4*)gp; gw1 = *(const u32x4*)(gp + 8); }
            LDS_BARRIER();
            { const int v0 = 16 * (tid & 7);
#pragma unroll
              for (int i = 0; i < 4; ++i) nv[i] = *(const f32x4*)(nw + v0 + 4 * i); }
            if (c < 7) HG_ISSUE(lfn, vvn, qvn, c + 1);
            bf16x8 ap[2];
#pragma unroll
            for (int k2 = 0; k2 < 2; ++k2) ap[k2] = *(const LAS bf16x8*)(L + HQ_PP + (16 * ti + fr) * LD64 + (32 * k2 + 8 * fq) * 2);
            float ss[4] = {0.f, 0.f, 0.f, 0.f};
#pragma unroll
            for (int q = 0; q < 4; ++q) { const int vj = 4 * (w & 1) + q; f32x4 ov = (f32x4){0.f, 0.f, 0.f, 0.f};
#pragma unroll
                for (int k2 = 0; k2 < 2; ++k2) { const bf16x8 bv = *(const LAS bf16x8*)(L + HQ_VT + (16 * vj + fr) * LD64 + (32 * k2 + 8 * fq) * 2); ov = __builtin_amdgcn_mfma_f32_16x16x32_bf16(ap[k2], bv, ov, 0, 0, 0); }
#pragma unroll
                for (int k2 = 0; k2 < 4; ++k2) { const bf16x8 bs = *(const LAS bf16x8*)(L + HQ_ST + (16 * vj + fr) * LD128 + (32 * k2 + 8 * fq) * 2); ov = __builtin_amdgcn_mfma_f32_16x16x32_bf16(aq[k2], bs, ov, 0, 0, 0); }
#pragma unroll
                for (int r = 0; r < 4; ++r) { *(LAS float*)(L + HQ_OT + (16 * ti + 4 * fq + r) * OTP + (16 * vj + fr) * 4) = ov[r]; ss[r] += ov[r] * ov[r]; } }
#pragma unroll
            for (int r = 0; r < 4; ++r) { float s = ss[r]; s += shfl_xor_l(s, 1, lane); s += shfl_xor_l(s, 2, lane); s += shfl_xor_l(s, 4, lane); s += shfl_xor_l(s, 8, lane);
                if (fr == 0) ((LAS float*)(L + HQ_NS))[(16 * ti + 4 * fq + r) * 2 + (w & 1)] = s; }
        }
        {
            bf16x8 ak[2];
#pragma unroll
            for (int k2 = 0; k2 < 2; ++k2) ak[k2] = *(const LAS bf16x8*)(L + HQ_KT + (16 * w + fr) * LD64 + (32 * k2 + 8 * fq) * 2);
            const f32x4 dc = *(const LAS f32x4*)(L + HQ_DC + (16 * w + 4 * fq) * 4);
#pragma unroll
            for (int vj = 0; vj < 8; ++vj) { f32x4 a = acc[vj] * dc;
#pragma unroll
                for (int k2 = 0; k2 < 2; ++k2) { const bf16x8 bv = *(const LAS bf16x8*)(L + HQ_VT + (16 * vj + fr) * LD64 + (32 * k2 + 8 * fq) * 2); a = __builtin_amdgcn_mfma_f32_16x16x32_bf16(ak[k2], bv, a, 0, 0, 0); }
                acc[vj] = a; }
        }
        LDS_BARRIER();
        if (OUT) {
            { const int t = tid >> 3, v0 = 16 * (tid & 7);
              const float tot = ((LAS float*)(L + HQ_NS))[t * 2] + ((LAS float*)(L + HQ_NS))[t * 2 + 1]; const float rs = 1.0f / sqrtf(tot * (1.0f / 128.0f) + eps_);
              f32x4 ox[4];
#pragma unroll
              for (int i = 0; i < 4; ++i) ox[i] = *(const LAS f32x4*)(L + HQ_OT + t * OTP + (v0 + 4 * i) * 4);
              const float g[16] = {bf_lo(gw0.x), bf_hi(gw0.x), bf_lo(gw0.y), bf_hi(gw0.y), bf_lo(gw0.z), bf_hi(gw0.z), bf_lo(gw0.w), bf_hi(gw0.w), bf_lo(gw1.x), bf_hi(gw1.x), bf_lo(gw1.y), bf_hi(gw1.y), bf_lo(gw1.z), bf_hi(gw1.z), bf_lo(gw1.w), bf_hi(gw1.w)};
              float y[16];
#pragma unroll
              for (int i = 0; i < 4; ++i)
#pragma unroll
                  for (int e = 0; e < 4; ++e) y[4 * i + e] = ox[i][e] * rs * nv[i][e] * g[4 * i + e];
              u32x4 w0, w1; w0.x = cvt_pk_bf16(y[0], y[1]); w0.y = cvt_pk_bf16(y[2], y[3]); w0.z = cvt_pk_bf16(y[4], y[5]); w0.w = cvt_pk_bf16(y[6], y[7]);
              w1.x = cvt_pk_bf16(y[8], y[9]); w1.y = cvt_pk_bf16(y[10], y[11]); w1.z = cvt_pk_bf16(y[12], y[13]); w1.w = cvt_pk_bf16(y[14], y[15]);
              bf16_t* op = WSP(bf16_t, WS_A2) + (size_t)(m0 + t) * D + 512 + hh * 128 + v0; *(u32x4*)op = w0; *(u32x4*)(op + 8) = w1; }
        }
    };
    if (OUT) { for (int c = 0; c < 8; ++c) chunk(lfA, vvA, qvA, lfA, vvA, qvA, c); }
    else { for (int c = 0; c < 8; c += 2) { chunk(lfA, vvA, qvA, lfB, vvB, qvB, c); chunk(lfB, vvB, qvB, lfA, vvA, qvA, c + 1); } }
#undef HG_ISSUE
    if (!OUT) { float* sl = WSP(float, WS_SL) + (size_t)item * 16384;
#pragma unroll
        for (int vj = 0; vj < 8; ++vj)
#pragma unroll
            for (int r = 0; r < 4; ++r) sl[(16 * w + 4 * fq + r) * 128 + 16 * vj + fr] = acc[vj][r];
        if (w == 0) SMP(f32x2, SM_DT)[item * 64 + lane] = (f32x2){fast_exp(gtot[0]), fast_exp(gtot[1])}; }
}
__device__ __forceinline__ void phase_scan(Ctx& C) {
    const float* SL = WSP(float, WS_SL); float* SI = WSP(float, WS_SI); const float* DT = SMP(float, SM_DT);
    for (int gid = C_BID * NT + C.tid; gid < 8 * 16384; gid += C_G * NT) {
        const int bh = gid >> 14, e = gid & 16383, k = e >> 7; float s = 0.f;
        float sl[31], dt[31];
#pragma unroll
        for (int j = 0; j < 31; ++j) { const size_t it = (size_t)(bh * 32 + j); sl[j] = SL[it * 16384 + e]; dt[j] = DT[it * 128 + k]; }
#pragma unroll
        for (int j = 0; j < 32; ++j) { SI[(size_t)(bh * 32 + j) * 16384 + e] = s; if (j < 31) s = dt[j] * s + sl[j]; }
    }
}

constexpr int NSTAGES = 26;

__global__ void __launch_bounds__(NT, 2) fwd(Args a) {
    extern __shared__ __attribute__((aligned(16))) unsigned char lds_raw[];
    Ctx C;
    C.lds = (LAS unsigned char*)lds_raw; C.tid = threadIdx.x; C.lane = C.tid & 63; C.wave = __builtin_amdgcn_readfirstlane(C.tid >> 6);
    int wave_s = C.wave;
    C.a = (const CAS Args*)__builtin_amdgcn_kernarg_segment_ptr();
    volatile LAS unsigned* MISC = (volatile LAS unsigned*)(C.lds + MISC_OFF);
    if (C.tid < 64) MISC[C.tid] = 0u;
    __syncthreads();
#if N_LAUNCHES == 1
    const int lo = 0, hi = NSTAGES;
    (void)xcd_barrier_post((unsigned*)(C_WS + WS_CTL) + CW_BAR, MISC + 8, C.tid);
#define SEAM() do { if (st + 1 < NSTAGES) { XcdBarrier bar_; bar_.bar = (unsigned*)(C_WS + WS_CTL) + CW_BAR; bar_.x = xb_xcc_id(); bar_.st = (volatile LAS unsigned*)(C.lds + MISC_OFF) + 8; unsigned mb_ = ~0u; asm volatile("" : "+s"(mb_), "+s"(wave_s)); const int tid_b = wave_s * 64 + (int)__builtin_amdgcn_mbcnt_hi(mb_, __builtin_amdgcn_mbcnt_lo(mb_, 0u)); xcd_barrier(bar_, tid_b); } } while (0)
#else
    const int lo = C.a->lo, hi = C.a->hi;
#define SEAM() do { } while (0)
#endif
    int st = 0;
#define STAGE_BEGIN(k) if (st >= lo && st < hi) { { unsigned m_ = ~0u; asm volatile("" : "+s"(m_), "+s"(wave_s)); C.lane = (int)__builtin_amdgcn_mbcnt_hi(m_, __builtin_amdgcn_mbcnt_lo(m_, 0u)); C.wave = wave_s; C.tid = wave_s * 64 + C.lane; } asm volatile("" : "+s"(C.a)); asm volatile("" : "+s"(C.lds)); C.G = gridDim.x; C.bid = blockIdx.x; asm volatile("" : "+s"(C.G), "+s"(C.bid));
#define STAGE_END } if (st >= lo && st < hi) { SEAM(); } ++st;
#define Hb WSP(bf16_t, WS_H)
    constexpr unsigned T1K = 256u * 1024 * 2;


    for (int l = 0; l < 2; ++l) {
        STAGE_BEGIN(1) if (l == 0) { phase_prologue(C); __syncthreads(); }
            phase_norm(C, l == 0 ? CIN(0) : C_OUT, l == 0 ? nullptr : C_OUT, CIN(1) + l * D, Hb, nullptr, WSP(bf16_t, WS_DN0), nullptr, l, nullptr, C_WS + WS_H8); STAGE_END
        STAGE_BEGIN(2) {
            {
                pg8::Gemm g{(const char*)C_WS, D, D, D};
                GridOrder S{(unsigned)WS_H, (unsigned)WS_WIN + (unsigned)l * (INC * D * 2), T1K, T1K, M / 256, (INC - NGATE) / 256, C_G, C_BID};
                EpiIn E{C_WS, CIN(3) + l * NGATE, l};
                pg8::gemm_phase<false>(C.lds, g, S, E, C.tid);
            }
            {
                pg8::Gemm g{(const char*)C_WS, D / 2, D / 2, D / 2};
                GridOrder S{(unsigned)WS_H8, (unsigned)WS_WG8 + (unsigned)l * (NGATE * D), 256u * D, 256u * D, M / 256, NGATE / 256, C_G, C_BID};
                EpiGate8 E{C_WS, CIN(3) + l * NGATE, 1.0f / (F8_H * F8_W)};
                pg8::gemm_phase<true>(C.lds, g, S, E, C.tid);
            }
        } STAGE_END
        STAGE_BEGIN(3) phase_pool(C); __syncthreads(); for (int it = C_BID; it < 256; it += C_G) hgrn_item<false>(C, it, nullptr); STAGE_END
        STAGE_BEGIN(4) phase_scan(C); STAGE_END
        STAGE_BEGIN(5) for (int it = C_BID; it < 256; it += C_G) hgrn_item<true>(C, it, CIN(8) + l * 128); STAGE_END
        STAGE_BEGIN(6) {
            pg8::Gemm g{(const char*)C_WS, D, D, 512};
            UOrder S{(unsigned)WS_A2, (unsigned)WS_WU + (unsigned)l * (D * D * 2), C_G, C_BID};
            EpiU E{C_WS};
            pg8::gemm_phase<false>(C.lds, g, S, E, C.tid);
        } STAGE_END
        STAGE_BEGIN(7) {
            pg8::Gemm g{(const char*)C_WS, D, D, D};
            GridOrder S{(unsigned)WS_H, (unsigned)WS_WOUT + (unsigned)l * (D * D * 2), T1K, T1K, M / 256, D / 256, C_G, C_BID};
            EpiRow E{WSP(bf16_t, WS_MO), D, nullptr, 1.0f};
            pg8::gemm_phase<false>(C.lds, g, S, E, C.tid);
        } STAGE_END
        STAGE_BEGIN(8) if (l == 0) phase_norm(C, CIN(0), C_OUT, CIN(11), Hb, nullptr, WSP(bf16_t, WS_MO), nullptr, 1, nullptr, nullptr);
            else { phase_norm_router(C, C_OUT, CIN(11) + D, WSP(bf16_t, WS_MO), C_WS + WS_H, CIN(15));     __syncthreads(); phase_moe_weights(C); } STAGE_END
        if (l == 1) {
            STAGE_BEGIN(9) phase_route(C); STAGE_END
            STAGE_BEGIN(10) phase_gather(C); STAGE_END
        }
        if (l == 0) {
            STAGE_BEGIN(11) {
                pg8::Gemm g{(const char*)C_WS, D, D, D};
                GuOrder S{(unsigned)WS_H, (unsigned)WS_DGU, nullptr, 0u, T1K, 0, 128, DFF0 / 128, C_G, C_BID};
                EpiSwi E{WSP(bf16_t, WS_ACT0), DFF0};
                pg8::gemm_phase<false>(C.lds, g, S, E, C.tid);
            } STAGE_END
            STAGE_BEGIN(12) {
                pg8::Gemm g{(const char*)C_WS, DFF0, DFF0, DFF0};
                DownOrder S{(unsigned)WS_ACT0, (unsigned)WS_DDN, nullptr, 0u, 256u * DFF0 * 2u, 0, 128, C_G, C_BID};
                EpiRow E{WSP(bf16_t, WS_DN0), D, nullptr, 1.0f};
                pg8::gemm_phase<false>(C.lds, g, S, E, C.tid);
            } STAGE_END
        } else {
            for (int gi = 0; gi < MOE_NG; ++gi) {
#define MOE_PARAMS() const int* texp = SMP(int, SM_TILEEXP); const int ntl = __builtin_amdgcn_readfirstlane(__hip_atomic_load(SMP(int, SM_NT), __ATOMIC_RELAXED, __HIP_MEMORY_SCOPE_AGENT)); \
                const int t0 = gi * MOE_G0; int nT = gi == 0 ? (ntl < MOE_G0 ? ntl : MOE_G0) : (ntl - MOE_G0); nT = nT < 0 ? 0 : nT;
                STAGE_BEGIN(14) {
                    MOE_PARAMS()
                    pg8::Gemm g{(const char*)C_WS, D / 2, D / 2, D / 2};
                    GuOrder S{(unsigned)WS_H2G, (unsigned)WS_MW, texp, (unsigned)MW_GU_E, 256u * D, t0, nT, DFF1 / 128, C_G, C_BID};
                    EpiSwi8 E{C_WS + WS_ACT1, DFF1, 1.0f / (F8_H * F8_W), F8_A};
                    pg8::gemm_phase<true>(C.lds, g, S, E, C.tid);
                } STAGE_END
                STAGE_BEGIN(15) {
                    MOE_PARAMS()
                    const int nTd = nT > 128 ? 128 : nT;
                    pg8::Gemm g{(const char*)C_WS, DFF1 / 2, DFF1 / 2, DFF1 / 2};
                    DownOrder S{(unsigned)WS_ACT1, (unsigned)WS_MWD, texp, (unsigned)MW_DN_E, 256u * DFF1, t0, nTd, C_G, C_BID};
                    EpiRow E{WSP(bf16_t, WS_DN1), D, SMP(float, SM_ROWSC), 1.0f / (F8_A * F8_W)};
                    pg8::gemm_phase<true>(C.lds, g, S, E, C.tid);
                } STAGE_END
            }
        }
    }
    STAGE_BEGIN(16) {
        const int* texp = SMP(int, SM_TILEEXP); const int ntl = __builtin_amdgcn_readfirstlane(__hip_atomic_load(SMP(int, SM_NT), __ATOMIC_RELAXED, __HIP_MEMORY_SCOPE_AGENT));
        const int nTt = ntl > 256 ? ntl - 256 : 0;
        {
            pg8::Gemm g{(const char*)C_WS, DFF1 / 2, DFF1 / 2, DFF1 / 2};
            DownOrder S{(unsigned)WS_ACT1 + 128u * (256u * DFF1), (unsigned)WS_MWD, texp, (unsigned)MW_DN_E, 256u * DFF1, 256, nTt, C_G, C_BID};
            EpiRow E{WSP(bf16_t, WS_DN1), D, SMP(float, SM_ROWSC), 1.0f / (F8_A * F8_W)};
            pg8::gemm_phase<true>(C.lds, g, S, E, C.tid);
        }
        phase_final(C, 1, nTt * 4);
    } STAGE_END
    STAGE_BEGIN(13) phase_final(C, 2, 0); STAGE_END
}


extern "C" void kernel_launch(void* const* d_in, const int* in_sizes, int n_in, void* d_out, int out_size, void* d_ws, size_t ws_size, hipStream_t stream) {
    static int grid = 0;
    if (grid == 0) {
        if (n_in != 20 || in_sizes[0] != M * D || out_size != M * D || ws_size < WS_END) { fprintf(stderr, "kernel_launch: unexpected sizes (n_in %d, out %d, ws %zu < %zu)\n", n_in, out_size, ws_size, (size_t)WS_END); grid = -1; return; }
        int dev = 0, cus = 0;
        if (hipGetDevice(&dev) != hipSuccess || hipDeviceGetAttribute(&cus, hipDeviceAttributeMultiprocessorCount, dev) != hipSuccess) { grid = -1; return; }
        if (hipFuncSetAttribute((const void*)fwd, hipFuncAttributeMaxDynamicSharedMemorySize, LDS_BYTES) != hipSuccess) { fprintf(stderr, "kernel_launch: hipFuncSetAttribute failed\n"); grid = -1; return; }
        int per_cu = 0;
        if (hipOccupancyMaxActiveBlocksPerMultiprocessor(&per_cu, (const void*)fwd, NT, LDS_BYTES) != hipSuccess || per_cu < 1) fprintf(stderr, "kernel_launch: occupancy query reports %d blocks per CU\n", per_cu);
        (void)hipGetLastError();
        if (cus != 256) { fprintf(stderr, "kernel_launch: built for a 256-CU device, found %d\n", cus); grid = -1; return; }
        grid = cus;
    }
    if (grid < 0) return;
    if (hipMemsetAsync((char*)d_ws + WS_CTL, 0, CTL_BYTES, stream) != hipSuccess) return;
    Args a{};
    for (int i = 0; i < 20; ++i) a.in[i] = (const float*)d_in[i];
    a.out = (float*)d_out; a.ws = (unsigned char*)d_ws;
#if N_LAUNCHES == 1
    a.lo = 0; a.hi = NSTAGES;
    hipLaunchKernelGGL(fwd, dim3(grid), dim3(NT), LDS_BYTES, stream, a);
#else
    for (int s = 0; s < NSTAGES; ++s) { a.lo = s; a.hi = s + 1; hipLaunchKernelGGL(fwd, dim3(grid), dim3(NT), LDS_BYTES, stream, a); }

#endif
}
```

```cpp
#include <hip/hip_runtime.h>
#include <cstdio>
#include <cstdint>
#include <type_traits>

#ifndef N_LAUNCHES
#define N_LAUNCHES 1
#endif

#define GAS __attribute__((address_space(1)))
#define LAS __attribute__((address_space(3)))
typedef unsigned short bf16_t;
typedef short bf16x8 __attribute__((ext_vector_type(8)));
typedef float f32x4 __attribute__((ext_vector_type(4)));
typedef float f32x2 __attribute__((ext_vector_type(2)));
typedef unsigned u32x4 __attribute__((ext_vector_type(4)));
typedef unsigned u32x2 __attribute__((ext_vector_type(2)));
typedef int i32x4 __attribute__((ext_vector_type(4)));
typedef int i32x8 __attribute__((ext_vector_type(8)));

constexpr int BATCH = 2, SEQ = 16384, D = 1024, M = BATCH * SEQ;
constexpr int PW = 512, HW = 512, INC = 4608, NGATE = 2048;
constexpr int DFF0 = 2816, DFF1 = 3584, NEXP = 8;
constexpr float EPS = 1e-6f;
constexpr int MAXTILES = 320;
constexpr int MAXSLOTS = MAXTILES * 256;

typedef __bf16 bf16x2_t __attribute__((ext_vector_type(2)));
__device__ __forceinline__ unsigned cvt_pk_bf16(float lo, float hi) { const bf16x2_t v = __builtin_convertvector((f32x2){lo, hi}, bf16x2_t); return __builtin_bit_cast(unsigned, v); }
__device__ __forceinline__ float f8_limit() { float l = 448.0f; asm volatile("" : "+s"(l)); return l; }
__device__ __forceinline__ float clamp_f8(float x, float lim) { return __builtin_amdgcn_fmed3f(x, -lim, lim); }
__device__ __forceinline__ unsigned pk4_fp8(float a, float b, float c, float d, float lim) {
    unsigned w = 0u; w = __builtin_amdgcn_cvt_pk_fp8_f32(clamp_f8(a, lim), clamp_f8(b, lim), w, false); w = __builtin_amdgcn_cvt_pk_fp8_f32(clamp_f8(c, lim), clamp_f8(d, lim), w, true); return w; }
__device__ __forceinline__ float bf_lo(unsigned w) { return __uint_as_float(w << 16); }
__device__ __forceinline__ float bf_hi(unsigned w) { return __uint_as_float(w & 0xffff0000u); }
__device__ __forceinline__ float bf2f(bf16_t b) { return __uint_as_float(((unsigned)b) << 16); }
__device__ __forceinline__ float fast_rcp(float x) { return __builtin_amdgcn_rcpf(x); }
__device__ __forceinline__ float fast_exp(float x) { return __builtin_amdgcn_exp2f(x * 1.44269504088896f); }
__device__ __forceinline__ float sigmoidf_(float x) { return fast_rcp(1.0f + fast_exp(-x)); }
__device__ __forceinline__ float siluf_(float x) { return x * sigmoidf_(x); }
__device__ __forceinline__ f32x2 sigmoid2(f32x2 x) { const f32x2 t = x * (f32x2){-1.44269504088896f, -1.44269504088896f}; f32x2 e; e.x = __builtin_amdgcn_exp2f(t.x); e.y = __builtin_amdgcn_exp2f(t.y);
    const f32x2 d = e + (f32x2){1.0f, 1.0f}; f32x2 r; r.x = __builtin_amdgcn_rcpf(d.x); r.y = __builtin_amdgcn_rcpf(d.y); return r; }
__device__ __forceinline__ f32x4 sigmoid4(f32x4 x) { const f32x2 a = sigmoid2((f32x2){x[0], x[1]}), b = sigmoid2((f32x2){x[2], x[3]}); return (f32x4){a.x, a.y, b.x, b.y}; }
__device__ __forceinline__ f32x4 silu4(f32x4 x) { return x * sigmoid4(x); }

namespace pg8 {
template <class E, class = void> struct epi_keep : std::false_type {};
template <class E> struct epi_keep<E, std::void_t<decltype(E::KEEP_ACC)>> : std::bool_constant<E::KEEP_ACC> {};
constexpr int BM = 256, BK = 64, HALF = 128, HTB = HALF * BK * 2, STAGE_BYTES = 8 * HTB, NXCD = 8, WGM = 8;
__host__ __device__ __forceinline__ int lds_byte(int r, int c) { const int st = (r >> 4) * 2 + (c >> 5), rr = r & 15, cc = c & 31, ob = rr * 64 + cc * 2; return st * 1024 + (ob ^ (((ob >> 9) & 1) << 5)); }
__host__ __device__ __forceinline__ void stage_rc(int b, int& R, int& C) { const int st = b / 1024, sb = b % 1024, swz = sb ^ (((sb >> 9) & 1) << 5); R = (st >> 1) * 16 + swz / 64; C = (st & 1) * 32 + (swz % 64) / 2; }
__host__ __device__ __forceinline__ int perm32(int rho) { const int n = rho >> 4, i = rho & 15; return 8 * (i >> 2) + 4 * n + (i & 3); }

struct Unit { unsigned A, B; int pm, pn, x; };
struct Gemm { const char* base; int lda, ldb, K; };

__device__ __forceinline__ bool grid_tile(int L, int nM, int nN, int& pm, int& pn) {
    const int nwg = nM * nN; if (L >= nwg) return false;
    int wgid = L; { const int q = nwg / NXCD, r = nwg % NXCD, xcd = wgid % NXCD, off = wgid / NXCD; wgid = (xcd < r ? xcd * (q + 1) : r * (q + 1) + (xcd - r) * q) + off; }
    const int nig = WGM * nN, gid = wgid / nig, fm = gid * WGM, gsz = (nM - fm) < WGM ? (nM - fm) : WGM;
    pm = fm + ((wgid % nig) % gsz); pn = (wgid % nig) / gsz; return true;
}

template <bool FP8, class Epi, class Sched>
__device__ __forceinline__ void gemm_phase(LAS unsigned char* lds, const Gemm g, const Sched& S, const Epi& E, int tid_in) {
    int tid_ = tid_in; asm volatile("" : "+v"(tid_));
    const int tid = tid_, wid = __builtin_amdgcn_readfirstlane(tid >> 6), lane = tid & 63, wr = wid >> 2, wc = wid & 3, fr = lane & 15, fq = lane >> 4;
    const int K = g.K, nt = K / BK;
    unsigned voffA, voffB;
    { int R, C; stage_rc(tid * 16, R, C); const int Rb = (R & ~31) + perm32(R & 31); voffA = (unsigned)(R * g.lda + C) * 2u; voffB = (unsigned)(Rb * g.ldb + C) * 2u; }
    const unsigned piecevoffA = 64u * (unsigned)g.lda * 2u, piecevoffB = 64u * (unsigned)g.ldb * 2u;
    const unsigned kstep = (unsigned)(BK * 2);
    const unsigned hstepA = (unsigned)HALF * g.lda * 2u, hstepB = (unsigned)HALF * g.ldb * 2u;
    const char* const gb = g.base;
    const unsigned ldsw = (unsigned)wid * 1024u;
    const int aoff = lds_byte(wr * 64 + fr, fq * 8), boff = lds_byte(wc * 32 + fr, fq * 8);
#define PG8_SA(b, h) (((b) * 2 + (h)) * HTB)
#define PG8_SB(b, h) ((4 + (b) * 2 + (h)) * HTB)
#define PG8_STAGE2(bufoff, gbase, voff, piece) do { _Pragma("unroll") for (int _i = 0; _i < 2; ++_i) \
        __builtin_amdgcn_global_load_lds((const unsigned*)((gb + (size_t)(unsigned)((gbase) + _i * (piece))) + (size_t)(voff)), (LAS unsigned*)(lds + (bufoff) + ldsw + _i * 8192), 16, 0, 0); } while (0)
#define PG8_STAGE(bufoff, gbase, voff) PG8_STAGE2(bufoff, gbase, voff, piece##voff)
#define PG8_LDA(dst, b, h) do { _Pragma("unroll") for (int m = 0; m < 4; ++m) _Pragma("unroll") for (int k = 0; k < 2; ++k) dst[m][k] = *(const LAS bf16x8*)(lds + PG8_SA(b, h) + aoff + m * 2048 + k * 1024); } while (0)
#define PG8_LDB(dst, b, h) do { _Pragma("unroll") for (int n = 0; n < 2; ++n) _Pragma("unroll") for (int k = 0; k < 2; ++k) dst[n][k] = *(const LAS bf16x8*)(lds + PG8_SB(b, h) + boff + n * 2048 + k * 1024); } while (0)
#define PG8_CAT(lo, hi) __builtin_shufflevector(__builtin_bit_cast(i32x4, lo), __builtin_bit_cast(i32x4, hi), 0, 1, 2, 3, 4, 5, 6, 7)
#define PG8_MMA(ai, bj, At, Bt) do { __builtin_amdgcn_s_setprio(1); _Pragma("unroll") for (int m = 0; m < 4; ++m) _Pragma("unroll") for (int n = 0; n < 2; ++n) { \
        if constexpr (FP8) acc[ai][bj][m][n] = __builtin_amdgcn_mfma_scale_f32_16x16x128_f8f6f4(PG8_CAT(Bt[n][0], Bt[n][1]), PG8_CAT(At[m][0], At[m][1]), acc[ai][bj][m][n], 0, 0, 0, 0, 0, 0);     \
        else { _Pragma("unroll") for (int k = 0; k < 2; ++k) acc[ai][bj][m][n] = __builtin_amdgcn_mfma_f32_16x16x32_bf16(Bt[n][k], At[m][k], acc[ai][bj][m][n], 0, 0, 0); } } \
        __builtin_amdgcn_s_setprio(0); } while (0)
#define PG8_WAIT_V(n) asm volatile("s_waitcnt vmcnt(" #n ")" ::: "memory")
#define PG8_WAIT_L(n) asm volatile("s_waitcnt lgkmcnt(" #n ")" ::: "memory")
#define PG8_BAR __builtin_amdgcn_s_barrier()
#define PG8_SCHED __builtin_amdgcn_sched_barrier(0)
    Unit cur, nxt; int ui = 0;
    if (!S.next(0, cur)) return;
    f32x4 acc[2][2][4][2];
#pragma unroll
    for (int a = 0; a < 2; ++a)
#pragma unroll
        for (int b = 0; b < 2; ++b)
#pragma unroll
            for (int m = 0; m < 4; ++m)
#pragma unroll
                for (int n = 0; n < 2; ++n) acc[a][b][m][n] = (f32x4){0.f, 0.f, 0.f, 0.f};
    bf16x8 At[4][2], B0[2][2], B1[2][2];
    unsigned cA = cur.A, cB = cur.B;
    PG8_STAGE(PG8_SB(0, 0), cB, voffB); PG8_STAGE(PG8_SB(0, 1), cB + hstepB, voffB); PG8_STAGE(PG8_SA(0, 0), cA, voffA); PG8_STAGE(PG8_SA(0, 1), cA + hstepA, voffA);
    if (wr == 1) PG8_BAR;
    PG8_WAIT_V(2); PG8_BAR;
    PG8_STAGE(PG8_SB(1, 0), cB + kstep, voffB); PG8_STAGE(PG8_SA(1, 0), cA + kstep, voffA); PG8_STAGE(PG8_SB(1, 1), cB + hstepB + kstep, voffB);
    PG8_WAIT_V(6); PG8_BAR;
    for (;;) {
        const bool has_next = S.next(ui + 1, nxt);
        const unsigned nA = has_next ? nxt.A : cA, nB = has_next ? nxt.B : cB;
#pragma unroll 1
        for (int t = 0; t < nt; t += 2) {
            const bool last = (t == nt - 2);
            const unsigned a1 = cA + (unsigned)(t + 1) * kstep;
            const unsigned a2 = last ? nA : cA + (unsigned)(t + 2) * kstep, b2 = last ? nB : cB + (unsigned)(t + 2) * kstep;
            const unsigned a3 = a2 + kstep, b3 = b2 + kstep;
            const bool relax = (t == 0) && (ui > 0);
#define PG8_WAIT_FIRST() do { if (relax && (Epi::NST != 0 || (epi_keep<Epi>::value && cur.x == 0))) { if constexpr (Epi::NST == 8) PG8_WAIT_V(16); else PG8_WAIT_V(24); } else PG8_WAIT_V(8); } while (0)
            PG8_LDB(B0, 0, 0); PG8_LDB(B1, 0, 1); PG8_SCHED; PG8_LDA(At, 0, 0); PG8_STAGE(PG8_SA(1, 1), a1 + hstepA, voffA);
            PG8_WAIT_FIRST(); PG8_WAIT_L(0); PG8_BAR; PG8_MMA(0, 0, At, B0); PG8_MMA(0, 1, At, B1); PG8_BAR; PG8_SCHED;
            PG8_LDA(At, 0, 1); PG8_STAGE(PG8_SB(0, 0), b2, voffB); PG8_STAGE(PG8_SB(0, 1), b2 + hstepB, voffB); PG8_STAGE(PG8_SA(0, 0), a2, voffA);
            PG8_WAIT_FIRST(); PG8_WAIT_L(0); PG8_BAR; PG8_MMA(1, 0, At, B0); PG8_MMA(1, 1, At, B1); PG8_BAR; PG8_SCHED;
            PG8_LDB(B0, 1, 0); PG8_LDB(B1, 1, 1); PG8_SCHED; PG8_LDA(At, 1, 0); PG8_STAGE(PG8_SA(0, 1), a2 + hstepA, voffA);
            PG8_WAIT_V(8); PG8_WAIT_L(0); PG8_BAR; PG8_MMA(0, 0, At, B0); PG8_MMA(0, 1, At, B1); PG8_BAR; PG8_SCHED;
            PG8_LDA(At, 1, 1); PG8_STAGE(PG8_SB(1, 0), b3, voffB); PG8_STAGE(PG8_SB(1, 1), b3 + hstepB, voffB); PG8_STAGE(PG8_SA(1, 0), a3, voffA);
            PG8_WAIT_V(8); PG8_WAIT_L(0); PG8_BAR; PG8_MMA(1, 0, At, B0); PG8_MMA(1, 1, At, B1); PG8_BAR; PG8_SCHED;
        }
        if (wr == 0) PG8_BAR;
        E(acc, cur, wr, wc, fr, fq);
        if (!has_next) break;
        bool zero_acc = true; if constexpr (epi_keep<Epi>::value) zero_acc = (cur.x != 0);
        if (zero_acc) {
#pragma unroll
        for (int a = 0; a < 2; ++a)
#pragma unroll
            for (int b = 0; b < 2; ++b)
#pragma unroll
                for (int m = 0; m < 4; ++m)
#pragma unroll
                    for (int n = 0; n < 2; ++n) acc[a][b][m][n] = (f32x4){0.f, 0.f, 0.f, 0.f};
        }
        cur = nxt; cA = nA; cB = nB; ++ui;
        if (wr == 1) PG8_BAR;
    }
    PG8_WAIT_V(0);
    PG8_BAR;
#undef PG8_SA
#undef PG8_SB
#undef PG8_STAGE
#undef PG8_STAGE2
#undef PG8_LDA
#undef PG8_LDB
#undef PG8_MMA
#undef PG8_WAIT_FIRST
#undef PG8_CAT
#undef PG8_WAIT_V
#undef PG8_WAIT_L
#undef PG8_BAR
#undef PG8_SCHED
}
}

constexpr size_t EPI_MiB = 1u << 20;
constexpr size_t EPI_WS_U = 111 * EPI_MiB, EPI_WS_Q = 143 * EPI_MiB, EPI_WS_LF = 175 * EPI_MiB, EPI_WS_V = 239 * EPI_MiB, EPI_WS_GG = 271 * EPI_MiB, EPI_WS_GT = 303 * EPI_MiB, EPI_WS_H = 47 * EPI_MiB, EPI_WS_LB = 1 * EPI_MiB;
typedef f32x4 AccT[2][2][4][2];
#define EPI_ROW0(u) ((u).pm * 256 + wr * 64 + fr)
__device__ __forceinline__ u32x4 pack8(const f32x4 a, const f32x4 b) { u32x4 w; w.x = cvt_pk_bf16(a[0], a[1]); w.y = cvt_pk_bf16(a[2], a[3]); w.z = cvt_pk_bf16(b[0], b[1]); w.w = cvt_pk_bf16(b[2], b[3]); return w; }

struct EpiIn {
    static constexpr int NST = 16;
    unsigned char* ws; const float* gbias; int layer;
    __device__ __forceinline__ void operator()(const AccT& acc, const pg8::Unit& u, int wr, int wc, int fr, int fq) const {
        unsigned char* wb = ws; asm volatile("" : "+s"(wb));
        GAS unsigned char* const wg = (GAS unsigned char*)wb;
        GAS bf16_t* const U = (GAS bf16_t*)(wg + EPI_WS_U); GAS bf16_t* const Q = (GAS bf16_t*)(wg + EPI_WS_Q); GAS bf16_t* const V = (GAS bf16_t*)(wg + EPI_WS_V); GAS bf16_t* const G = (GAS bf16_t*)(wg + EPI_WS_GG); GAS bf16_t* const GT = (GAS bf16_t*)(wg + EPI_WS_GT);
        GAS float* const LF = (GAS float*)(wg + EPI_WS_LF); const GAS float* const lb = (const GAS float*)(wg + EPI_WS_LB) + layer * HW;
        const int row0 = EPI_ROW0(u), cw = wc * 32 + 8 * fq;
        if (u.pn >= 10) {
            const int c0 = (u.pn - 10) * 256 + cw;
            f32x4 bb[2][2];
#pragma unroll
            for (int bj = 0; bj < 2; ++bj) { bb[bj][0] = *(const f32x4*)(gbias + c0 + bj * 128); bb[bj][1] = *(const f32x4*)(gbias + c0 + bj * 128 + 4); }
#pragma unroll
            for (int bj = 0; bj < 2; ++bj) { const int c = c0 + bj * 128; const f32x4 b0 = bb[bj][0], b1 = bb[bj][1];
#pragma unroll
                for (int ai = 0; ai < 2; ++ai)
#pragma unroll
                    for (int m = 0; m < 4; ++m) { f32x4 v0 = acc[ai][bj][m][0] + b0, v1 = acc[ai][bj][m][1] + b1;
#pragma unroll
                        for (int j = 0; j < 4; ++j) { v0[j] = sigmoidf_(v0[j]); v1[j] = sigmoidf_(v1[j]); }
                        __builtin_nontemporal_store(pack8(v0, v1), (GAS u32x4*)(GT + (size_t)(row0 + ai * 128 + m * 16) * NGATE + c)); } }
        } else if ((u.pn >> 1) == 2) {
            const int c0 = (u.pn - 4) * 256 + cw;
            f32x4 ll[2][2];
#pragma unroll
            for (int bj = 0; bj < 2; ++bj) { ll[bj][0] = *(const GAS f32x4*)(lb + c0 + bj * 128); ll[bj][1] = *(const GAS f32x4*)(lb + c0 + bj * 128 + 4); }
#pragma unroll
            for (int bj = 0; bj < 2; ++bj) { const int c = c0 + bj * 128; const f32x4 l0 = ll[bj][0], l1 = ll[bj][1];
#pragma unroll
                for (int ai = 0; ai < 2; ++ai)
#pragma unroll
                    for (int m = 0; m < 4; ++m) { f32x4 v0 = acc[ai][bj][m][0], v1 = acc[ai][bj][m][1];
                        { const f32x4 s0 = sigmoid4(v0), s1 = sigmoid4(v1); const f32x4 f0 = __builtin_elementwise_max(l0, (f32x4){1e-30f, 1e-30f, 1e-30f, 1e-30f}) + ((f32x4){1.f, 1.f, 1.f, 1.f} - l0) * s0, f1 = __builtin_elementwise_max(l1, (f32x4){1e-30f, 1e-30f, 1e-30f, 1e-30f}) + ((f32x4){1.f, 1.f, 1.f, 1.f} - l1) * s1;
#pragma unroll
                          for (int j = 0; j < 4; ++j) { v0[j] = __logf(f0[j]); v1[j] = __logf(f1[j]); } }
                        GAS float* o = LF + (size_t)(row0 + ai * 128 + m * 16) * HW + c; *(GAS f32x4*)o = v0; *(GAS f32x4*)(o + 4) = v1; } }
        } else {
            const int kind = u.pn >> 1; GAS bf16_t* dst = kind == 0 ? U : (kind == 1 ? Q : (kind == 3 ? V : G)); const bool act = (kind == 1) || (kind == 4);
            const int c0 = (u.pn & 1) * 256 + cw;
#pragma unroll
            for (int bj = 0; bj < 2; ++bj) { const int c = c0 + bj * 128;
#pragma unroll
                for (int ai = 0; ai < 2; ++ai)
#pragma unroll
                    for (int m = 0; m < 4; ++m) { f32x4 v0 = acc[ai][bj][m][0], v1 = acc[ai][bj][m][1];
                        if (act) { v0 = silu4(v0); v1 = silu4(v1); }
                        *(GAS u32x4*)(dst + (size_t)(row0 + ai * 128 + m * 16) * PW + c) = pack8(v0, v1); } }
        }
    }
};
struct EpiGate8 {
    static constexpr int NST = 16;
    unsigned char* ws; const float* gbias; float cs;
    __device__ __forceinline__ void operator()(const AccT& acc, const pg8::Unit& u, int wr, int wc, int fr, int fq) const {
        unsigned char* wb = ws; float csl = cs; asm volatile("" : "+s"(wb), "+s"(csl));
        GAS unsigned char* const GT8 = (GAS unsigned char*)wb + EPI_WS_GT;
        const int row0 = EPI_ROW0(u), c0 = u.pn * 256 + wc * 32 + 8 * fq;
        const float qlo = (u.pn >= 4) ? 1.0f : 0.0f; float k255 = 255.0f; asm volatile("" : "+s"(k255));
        f32x4 bb[2][2];
#pragma unroll
        for (int bj = 0; bj < 2; ++bj) { bb[bj][0] = *(const f32x4*)(gbias + c0 + bj * 128); bb[bj][1] = *(const f32x4*)(gbias + c0 + bj * 128 + 4); }
#pragma unroll
        for (int bj = 0; bj < 2; ++bj) { const int c = c0 + bj * 128;
#pragma unroll
            for (int ai = 0; ai < 2; ++ai)
#pragma unroll
                for (int m = 0; m < 4; ++m) { f32x4 v0 = acc[ai][bj][m][0] * csl + bb[bj][0], v1 = acc[ai][bj][m][1] * csl + bb[bj][1];
                    v0 = sigmoid4(v0) * k255; v1 = sigmoid4(v1) * k255;
                    u32x2 w; w.x = 0u; w.y = 0u;
#pragma unroll
                    for (int j = 0; j < 4; ++j) { w.x = __builtin_amdgcn_cvt_pk_u8_f32(fmaxf(v0[j], qlo), j, w.x); w.y = __builtin_amdgcn_cvt_pk_u8_f32(fmaxf(v1[j], qlo), j, w.y); }
                    __builtin_nontemporal_store(w, (GAS u32x2*)(GT8 + (size_t)(row0 + ai * 128 + m * 16) * NGATE + c)); } }
    }
};
struct EpiU {
    static constexpr bool KEEP_ACC = true;
    static constexpr int NST = 0;
    unsigned char* ws;
    __device__ __forceinline__ void operator()(AccT& acc, const pg8::Unit& u, int wr, int wc, int fr, int fq) const {
        unsigned char* wb = ws; asm volatile("" : "+s"(wb));
        GAS unsigned char* const wg = (GAS unsigned char*)wb;
        GAS bf16_t* const MG = (GAS bf16_t*)(wg + EPI_WS_H); const GAS unsigned char* const GT8 = wg + EPI_WS_GT;
        const int row0 = EPI_ROW0(u), c0 = u.pn * 256 + wc * 32 + 8 * fq;
        float one = 1.0f, i255 = 1.0f / 255.0f; asm volatile("" : "+s"(one), "+s"(i255));
#define EPU_BYTE(w_, j_) ((float)(((w_) >> (8 * (j_))) & 0xffu))
        if (u.x == 0) {
#pragma unroll
            for (int ai = 0; ai < 2; ++ai) {
                u32x2 ga[4][2], gb[4][2];
#pragma unroll
                for (int m = 0; m < 4; ++m)
#pragma unroll
                    for (int bj = 0; bj < 2; ++bj) { const size_t row = (size_t)(row0 + ai * 128 + m * 16); const int c = c0 + bj * 128;
                        ga[m][bj] = __builtin_nontemporal_load((const GAS u32x2*)(GT8 + row * NGATE + c)); gb[m][bj] = *(const GAS u32x2*)(GT8 + row * NGATE + 1024 + c); }
#pragma unroll
                for (int m = 0; m < 4; ++m)
#pragma unroll
                    for (int bj = 0; bj < 2; ++bj) { const u32x2 a = ga[m][bj], b = gb[m][bj];
#pragma unroll
                        for (int j = 0; j < 4; ++j) { acc[ai][bj][m][0][j] *= EPU_BYTE(a.x, j) * __builtin_amdgcn_rcpf(fmaxf(EPU_BYTE(b.x, j), one));
                                                      acc[ai][bj][m][1][j] *= EPU_BYTE(a.y, j) * __builtin_amdgcn_rcpf(fmaxf(EPU_BYTE(b.y, j), one)); } }
                asm volatile("" ::: "memory"); __builtin_amdgcn_sched_barrier(0);
            }
        } else {
#pragma unroll
            for (int ai = 0; ai < 2; ++ai) {
                u32x2 gb[4][2];
#pragma unroll
                for (int m = 0; m < 4; ++m)
#pragma unroll
                    for (int bj = 0; bj < 2; ++bj) gb[m][bj] = __builtin_nontemporal_load((const GAS u32x2*)(GT8 + (size_t)(row0 + ai * 128 + m * 16) * NGATE + 1024 + c0 + bj * 128));
#pragma unroll
                for (int m = 0; m < 4; ++m)
#pragma unroll
                    for (int bj = 0; bj < 2; ++bj) { const size_t row = (size_t)(row0 + ai * 128 + m * 16); const int c = c0 + bj * 128; const u32x2 g = gb[m][bj];
                        f32x4 v0 = acc[ai][bj][m][0], v1 = acc[ai][bj][m][1];
#pragma unroll
                        for (int j = 0; j < 4; ++j) { v0[j] *= EPU_BYTE(g.x, j) * i255; v1[j] *= EPU_BYTE(g.y, j) * i255; }
                        *(GAS u32x4*)(MG + row * D + c) = pack8(v0, v1); }
            }
        }
#undef EPU_BYTE
    }
};
struct EpiRow {
    static constexpr int NST = 16;
    bf16_t* O; int ldo; const float* rowscale; float cs;
    __device__ __forceinline__ void operator()(const AccT& acc, const pg8::Unit& u, int wr, int wc, int fr, int fq) const {
        const int row0 = EPI_ROW0(u), c0 = u.pn * 256 + wc * 32 + 8 * fq; float csl = cs; asm volatile("" : "+s"(csl));
        float sc[2][4];
#pragma unroll
        for (int ai = 0; ai < 2; ++ai)
#pragma unroll
            for (int m = 0; m < 4; ++m) sc[ai][m] = rowscale ? rowscale[row0 + ai * 128 + m * 16] * csl : csl;
#pragma unroll
        for (int ai = 0; ai < 2; ++ai)
#pragma unroll
            for (int m = 0; m < 4; ++m) { const size_t row = (size_t)(row0 + ai * 128 + m * 16); const float s = sc[ai][m];
#pragma unroll
                for (int bj = 0; bj < 2; ++bj) *(u32x4*)(O + row * ldo + c0 + bj * 128) = pack8(acc[ai][bj][m][0] * s, acc[ai][bj][m][1] * s); }
    }
};
struct EpiSwi {
    static constexpr int NST = 8;
    bf16_t* ACT; int ldact;
    __device__ __forceinline__ void operator()(const AccT& acc, const pg8::Unit& u, int wr, int wc, int fr, int fq) const {
        const int row0 = u.x * 256 + wr * 64 + fr, c0 = u.pn * 128 + wc * 32 + 8 * fq;
#pragma unroll
        for (int ai = 0; ai < 2; ++ai)
#pragma unroll
            for (int m = 0; m < 4; ++m) { f32x4 v0 = acc[ai][0][m][0], v1 = acc[ai][0][m][1]; const f32x4 u0 = acc[ai][1][m][0], u1 = acc[ai][1][m][1];
                v0 = silu4(v0) * u0; v1 = silu4(v1) * u1;
                *(u32x4*)(ACT + (size_t)(row0 + ai * 128 + m * 16) * ldact + c0) = pack8(v0, v1); }
    }
};

struct EpiSwi8 {
    static constexpr int NST = 8;
    unsigned char* ACT; int ldact; float in_scale, out_scale;
    __device__ __forceinline__ void operator()(const AccT& acc, const pg8::Unit& u, int wr, int wc, int fr, int fq) const {
        const int row0 = u.x * 256 + wr * 64 + fr, c0 = u.pn * 128 + wc * 32 + 8 * fq; const float lim = f8_limit();
        float kE_ = -in_scale * 1.44269504088896f, kU_ = in_scale * in_scale * out_scale; asm volatile("" : "+s"(kE_), "+s"(kU_));
        const f32x2 kE = {kE_, kE_}, kU = {kU_, kU_}, one = {1.0f, 1.0f};
#pragma unroll
        for (int ai = 0; ai < 2; ++ai)
#pragma unroll
            for (int m = 0; m < 4; ++m) { unsigned w[2];
#pragma unroll
                for (int n = 0; n < 2; ++n) { const f32x4 g4 = acc[ai][0][m][n], u4 = acc[ai][1][m][n]; f32x2 o[2];
#pragma unroll
                    for (int h = 0; h < 2; ++h) { const f32x2 g = {g4[2 * h], g4[2 * h + 1]}, uu = {u4[2 * h], u4[2 * h + 1]};
                        const f32x2 t = g * kE; f32x2 e; e.x = __builtin_amdgcn_exp2f(t.x); e.y = __builtin_amdgcn_exp2f(t.y);
                        const f32x2 d = e + one; f32x2 r; r.x = __builtin_amdgcn_rcpf(d.x); r.y = __builtin_amdgcn_rcpf(d.y);
                        o[h] = (g * r) * (uu * kU); }
                    w[n] = pk4_fp8(o[0].x, o[0].y, o[1].x, o[1].y, lim); }
                u32x2 ww; ww.x = w[0]; ww.y = w[1];
                *(u32x2*)(ACT + (size_t)(row0 + ai * 128 + m * 16) * ldact + c0) = ww;
                __builtin_amdgcn_sched_barrier(0); }
    }
};

struct GridOrder {
    unsigned Abase, Bbase, atile, btile; int nM, nN, G, c;
    __device__ __forceinline__ bool next(int i, pg8::Unit& u) const {
        int pm, pn; if (!pg8::grid_tile(i * G + c, nM, nN, pm, pn)) return false;
        u.pm = pm; u.pn = pn; u.x = 0; u.A = Abase + (unsigned)pm * atile; u.B = Bbase + (unsigned)pn * btile; return true; }
};
struct UOrder {
    unsigned Abase, Bbase; int G, c;
    __device__ __forceinline__ bool next(int i, pg8::Unit& u) const {
        int pm, pn; if (!pg8::grid_tile((i >> 1) * G + c, M / 256, D / 256, pm, pn)) return false;
        u.pm = pm; u.pn = pn; u.x = i & 1; u.A = Abase + (unsigned)pm * (256u * 1024 * 2) + (unsigned)(i & 1) * 1024u; u.B = Bbase + (unsigned)pn * (256u * 1024 * 2) + (unsigned)(i & 1) * 1024u; return true; }
};
struct GuOrder {
    unsigned Abase, Bbase; const int* tile_expert; unsigned bexp, tileb; int t0, nT, nN, G, c;
    __device__ __forceinline__ bool next(int i, pg8::Unit& u) const {
        int pm, pn; if (!pg8::grid_tile(i * G + c, nT, nN, pm, pn)) return false;
        const int tile = t0 + pm; const int e = tile_expert ? __builtin_amdgcn_readfirstlane(__hip_atomic_load(tile_expert + tile, __ATOMIC_RELAXED, __HIP_MEMORY_SCOPE_AGENT)) : 0;
        u.pm = tile; u.pn = pn; u.x = pm; u.A = Abase + (unsigned)tile * tileb; u.B = Bbase + (unsigned)e * bexp + (unsigned)pn * tileb; return true; }
};
struct DownOrder {
    unsigned Abase, Bbase; const int* tile_expert; unsigned bexp, atile; int t0, nT, G, c;
    __device__ __forceinline__ bool next(int i, pg8::Unit& u) const {
        int pm, pn; if (!pg8::grid_tile(i * G + c, nT, D / 256, pm, pn)) return false;
        const int tile = t0 + pm; const int e = tile_expert ? __builtin_amdgcn_readfirstlane(__hip_atomic_load(tile_expert + tile, __ATOMIC_RELAXED, __HIP_MEMORY_SCOPE_AGENT)) : 0;
        u.pm = tile; u.pn = pn; u.x = pm; u.A = Abase + (unsigned)pm * atile; u.B = Bbase + (unsigned)e * bexp + (unsigned)pn * atile; return true; }
};

constexpr size_t MiB = 1u << 20;
constexpr size_t WS_CTL = 0, CTL_BYTES = 1 * MiB;
constexpr size_t WS_SMALL = 1 * MiB;
constexpr size_t SM_LB = 0, SM_CNTWG = 4096, SM_TOKE = 16384, SM_TOKW = 147456, SM_TOKS = 409600, SM_ROWIDX = 671744, SM_ROWSC = 999424, SM_TILEEXP = 1327104, SM_NT = 1328384, SM_DT = 1536 * 1024;
constexpr int MAXT = 272, NSLOT = MAXT * 256;
static_assert(SM_ROWIDX + (size_t)NSLOT * 4 <= SM_ROWSC && SM_ROWSC + (size_t)NSLOT * 4 <= SM_TILEEXP && SM_DT + 256 * 128 * 4 <= 3 * MiB, "small map");
constexpr size_t WS_WIN = 4 * MiB, WS_WU = 22 * MiB, WS_WOUT = 26 * MiB, WS_DGU = 30 * MiB, WS_DDN = 41 * MiB;
constexpr size_t WS_H = 47 * MiB;
constexpr size_t WS_U = 111 * MiB, WS_Q = 143 * MiB, WS_LF = 175 * MiB, WS_V = 239 * MiB, WS_GG = 271 * MiB, WS_GT = 303 * MiB, WS_A2 = 431 * MiB, WS_SL = 495 * MiB, WS_SI = 511 * MiB;
constexpr size_t WS_H8 = WS_SL;
constexpr size_t WS_WG8 = 528 * MiB;
constexpr size_t WS_MO = 111 * MiB;
constexpr size_t WS_ACT0 = 111 * MiB, WS_DN0 = 287 * MiB;
constexpr size_t WS_ACT1 = 111 * MiB, WS_H2G = 237 * MiB, WS_DN1 = 305 * MiB, WS_MW = 441 * MiB;
constexpr int MOE_G0 = 128, MOE_G1 = 144, MOE_NG = 2;
constexpr size_t MW_GU_E = (size_t)2 * DFF1 * D, MW_DN_E = (size_t)D * DFF1;
constexpr size_t WS_MWD = WS_MW + NEXP * MW_GU_E;
constexpr size_t WS_END = 548 * MiB;
constexpr float F8_W = 256.0f, F8_H = 16.0f, F8_A = 8.0f;
static_assert(WS_MWD + NEXP * MW_DN_E <= WS_END && WS_H2G + (size_t)NSLOT * D <= WS_DN1 && WS_DN1 + (size_t)NSLOT * D * 2 <= WS_MW && WS_ACT1 + (size_t)MOE_G1 * 256 * DFF1 <= WS_H2G && MOE_G0 + MOE_G1 >= MAXT && WS_SI + 16 * MiB <= WS_END, "ws map");
static_assert(EPI_WS_U == WS_U && EPI_WS_Q == WS_Q && EPI_WS_LF == WS_LF && EPI_WS_V == WS_V && EPI_WS_GG == WS_GG && EPI_WS_GT == WS_GT && EPI_WS_H == WS_H && EPI_WS_LB == WS_SMALL + SM_LB, "epilogue offsets");
static_assert(WS_ACT0 + (size_t)M * DFF0 * 2 <= WS_DN0 && WS_DDN + (size_t)D * DFF0 * 2 <= WS_H, "ws map 2");
constexpr int CW_BAR = 4096;

constexpr int RING_BYTES = 131072, MISC_OFF = RING_BYTES, LDS_BYTES = 147456;
constexpr int NW = 8, NT = 512;
#define LDS_WAIT() asm volatile("s_waitcnt lgkmcnt(0)" ::: "memory")
#define LDS_BARRIER() asm volatile("s_waitcnt lgkmcnt(0)\n\ts_barrier" ::: "memory")
#define VM_WAIT() asm volatile("s_waitcnt vmcnt(0)" ::: "memory")

#define XB_TMO      128
#define XB_XCNT(j)  (256  + 64 * (j))
#define XB_XSUB(j)  (1280 + 64 * (j))
#define XB_XGEN(j)  (2304 + 64 * (j))
#define XB_TOP      3328
#define XB_TOPGEN   3392
#define XCD_BAR_WORDS 3456
#define XB_SPIN_CAP (1u << 18)
__device__ __forceinline__ unsigned xb_ld(unsigned* p)              { return __hip_atomic_load(p, __ATOMIC_RELAXED, __HIP_MEMORY_SCOPE_AGENT); }
__device__ __forceinline__ unsigned xb_add(unsigned* p, unsigned v) { return __hip_atomic_fetch_add(p, v, __ATOMIC_RELAXED, __HIP_MEMORY_SCOPE_AGENT); }
__device__ __forceinline__ unsigned xb_xcc_id() { return (unsigned)__builtin_amdgcn_s_getreg((3 << 11) | 20) & 0xFu; }
#define XB_SPIN(cond, bar) do { unsigned _sp = 0; while (cond) { __builtin_amdgcn_s_sleep(1); \
    if ((++_sp & 255u) == 0u) { if (xb_ld(&(bar)[XB_TMO])) break; if (_sp > XB_SPIN_CAP) { atomicAdd(&(bar)[XB_TMO], 1u); break; } } } } while (0)
struct XcdBarrier { unsigned* bar; unsigned x; volatile LAS unsigned* st; };
__device__ __forceinline__ XcdBarrier xcd_barrier_post(unsigned* bar, volatile LAS unsigned* st, int tid) {
    XcdBarrier b; b.bar = bar; b.x = xb_xcc_id(); b.st = st;
    if (tid == 0) (void)xb_add(&bar[XB_XCNT(b.x)], 1u);
    return b;
}
__device__ __forceinline__ void xcd_barrier_complete(unsigned* bar, unsigned x, unsigned& nloc, unsigned& nx) {
    const unsigned G = gridDim.x * gridDim.y * gridDim.z;
    unsigned sum, cnt, mine, sp = 0u;
    for (;;) {
        sum = 0u; cnt = 0u; mine = 0u;
#pragma unroll
        for (unsigned j = 0; j < 16; ++j) { const unsigned c = xb_ld(&bar[XB_XCNT(j)]); sum += c; cnt += (c > 0u) ? 1u : 0u; mine = (j == x) ? c : mine; }
        if (sum == G) break;
        __builtin_amdgcn_s_sleep(1);
        if ((++sp & 255u) == 0u) { if (xb_ld(&bar[XB_TMO])) break; if (sp > XB_SPIN_CAP) { atomicAdd(&bar[XB_TMO], 1u); break; } }
    }
    nloc = mine > 0u ? mine : 1u; nx = cnt > 0u ? cnt : 1u;
}
__device__ __forceinline__ void xcd_barrier(const XcdBarrier& b, int tid) {
    asm volatile("s_waitcnt vmcnt(0)" ::: "memory");
    __syncthreads();
    if (tid == 0) {
        unsigned* bar = b.bar;
        __builtin_amdgcn_s_waitcnt(0);
        unsigned nloc = b.st[0], nx = b.st[1];
        if (nloc == 0u) { xcd_barrier_complete(bar, b.x, nloc, nx); b.st[0] = nloc; b.st[1] = nx; }
        const unsigned old = xb_add(&bar[XB_XSUB(b.x)], 1u);
        const unsigned gen = old / nloc;
        if (old + 1u == (gen + 1u) * nloc) {
            __builtin_amdgcn_fence(__ATOMIC_RELEASE, "agent");
            asm volatile("s_waitcnt vmcnt(0)" ::: "memory");
            const unsigned og = xb_add(&bar[XB_TOP], 1u);
            const unsigned tg = og / nx;
            if (og + 1u == (tg + 1u) * nx) xb_add(&bar[XB_TOPGEN], 1u);
            else XB_SPIN(xb_ld(&bar[XB_TOPGEN]) == tg, bar);
            __builtin_amdgcn_fence(__ATOMIC_ACQUIRE, "agent");
            xb_add(&bar[XB_XGEN(b.x)], 1u);
            asm volatile("s_waitcnt vmcnt(0)" ::: "memory");
        } else {
            XB_SPIN(xb_ld(&bar[XB_XGEN(b.x)]) == gen, bar);
            __builtin_amdgcn_fence(__ATOMIC_ACQUIRE, "agent");
            asm volatile("s_waitcnt vmcnt(0)" ::: "memory");
        }
    }
    __syncthreads();
}

__device__ __forceinline__ float shfl_xor_l(float v, int o, int lane) { return __builtin_bit_cast(float, __builtin_amdgcn_ds_bpermute((lane ^ o) << 2, __builtin_bit_cast(int, v))); }
template <int N> __device__ __forceinline__ float row_ror(float v) { return __builtin_bit_cast(float, __builtin_amdgcn_update_dpp(0, __builtin_bit_cast(int, v), 0x120 + N, 0xf, 0xf, false)); }
__device__ __forceinline__ float wave_sum(float v, int lane) {
#pragma unroll
    for (int o = 1; o < 64; o <<= 1) v += shfl_xor_l(v, o, lane);
    return v;
}
__device__ __forceinline__ void tr_item(const float* W, int N, int k0, int n0, bf16_t* dst, int ldd, LAS float* scr, int lane) {
    float v[32];
#pragma unroll
    for (int i = 0; i < 32; ++i) v[i] = __builtin_nontemporal_load(W + (size_t)(k0 + 2 * i + (lane >> 5)) * N + n0 + (lane & 31));
#pragma unroll
    for (int i = 0; i < 32; ++i) scr[(2 * i + (lane >> 5)) * 33 + (lane & 31)] = v[i];
    LDS_WAIT();
    const int c = lane & 7;
#pragma unroll
    for (int j = 0; j < 4; ++j) { const int n = (lane >> 3) + 8 * j; const LAS float* s = scr + (8 * c) * 33 + n;
        u32x4 o; o.x = cvt_pk_bf16(s[0 * 33], s[1 * 33]); o.y = cvt_pk_bf16(s[2 * 33], s[3 * 33]); o.z = cvt_pk_bf16(s[4 * 33], s[5 * 33]); o.w = cvt_pk_bf16(s[6 * 33], s[7 * 33]);
        *(u32x4*)(dst + (size_t)n * ldd + 8 * c) = o; }
    LDS_WAIT();
}
__device__ __forceinline__ void tr_item8(const float* W, int N, int k0, int n0, unsigned char* dst, int ldd, float scale, LAS float* scr, int lane) {
    float v[32];
#pragma unroll
    for (int i = 0; i < 32; ++i) v[i] = __builtin_nontemporal_load(W + (size_t)(k0 + 2 * i + (lane >> 5)) * N + n0 + (lane & 31));
#pragma unroll
    for (int i = 0; i < 32; ++i) scr[(2 * i + (lane >> 5)) * 33 + (lane & 31)] = v[i] * scale;
    LDS_WAIT();
    const int c = lane & 7; const float lim = f8_limit();
#pragma unroll
    for (int j = 0; j < 4; ++j) { const int n = (lane >> 3) + 8 * j; const LAS float* s = scr + (8 * c) * 33 + n;
        u32x2 o; o.x = pk4_fp8(s[0 * 33], s[1 * 33], s[2 * 33], s[3 * 33], lim); o.y = pk4_fp8(s[4 * 33], s[5 * 33], s[6 * 33], s[7 * 33], lim);
        *(u32x2*)(dst + (size_t)n * ldd + 8 * c) = o; }
    LDS_WAIT();
}
__device__ __forceinline__ void tr_plain(const float* W, int K, int N, bf16_t* WT, int ldd, int kcol0, int it, LAS float* scr, int lane) {
    const int nblk = N / 32, kb = it / nblk, nb = it % nblk;
    tr_item(W, N, 64 * kb, 32 * nb, WT + (size_t)(32 * nb) * ldd + kcol0 + 64 * kb, ldd, scr, lane);
}
__device__ __forceinline__ void tr_gu(const float* W, int dff, int isup, bf16_t* WT, int it, LAS float* scr, int lane) {
    const int nblk = dff / 32, kb = it / nblk, nb = it % nblk, n0 = 32 * nb, drow = 256 * (n0 >> 7) + 128 * isup + (n0 & 127);
    tr_item(W, dff, 64 * kb, n0, WT + (size_t)drow * D + 64 * kb, D, scr, lane);
}

struct Args { const float* in[20]; float* out; unsigned char* ws; int lo, hi; };
#define CAS __attribute__((address_space(4)))
struct Ctx {
    LAS unsigned char* lds; int tid, lane, wave, G, bid;
    const CAS Args* a;
};
#define CIN(i) (C.a->in[i])
#define XB_ROW(base_, row_) ((u32x2*)((char*)(base_) + (size_t)(row_) * (D * 4) + D * 2))
#define C_WS (C.a->ws)
#define C_OUT (C.a->out)
#define C_G (C.G)
#define C_BID (C.bid)
#define WSP(T, off) ((T*)(C_WS + (off)))
#define SMP(T, off) ((T*)(C_WS + WS_SMALL + (off)))

__device__ __forceinline__ void phase_prologue(Ctx& C) {
    LAS float* scr = (LAS float*)(C.lds + C.wave * 16384);
    const int gw = C_BID * NW + C.wave, NGW = C_G * NW;
    constexpr int I_IN = (D / 64) * ((INC - NGATE) / 32), I_HU = (HW / 64) * (D / 32), I_WO = (D / 64) * (D / 32), I_GU = (D / 64) * (DFF0 / 32), I_DN = (DFF0 / 64) * (D / 32);
    constexpr int I_G8 = (D / 64) * (NGATE / 32);
    constexpr int NITEMS = 2 * (I_IN + I_HU + I_WO) + 2 * I_GU + I_DN + 2 * I_G8;
    for (int it = gw; it < NITEMS; it += NGW) {
        int r = it;
        if (r < 2 * I_IN) { const int l = r / I_IN, q = r % I_IN, nblk = (INC - NGATE) / 32, kb = q / nblk, nb = q % nblk;
            tr_item(CIN(2) + (size_t)l * D * INC, INC, 64 * kb, 32 * nb, WSP(bf16_t, WS_WIN) + (size_t)l * INC * D + (size_t)(32 * nb) * D + 64 * kb, D, scr, C.lane); continue; } r -= 2 * I_IN;
        if (r < 2 * I_HU) { const int l = r / I_HU; tr_plain(CIN(9) + (size_t)l * HW * D, HW, D, WSP(bf16_t, WS_WU) + (size_t)l * D * D, D, 512, r % I_HU, scr, C.lane); continue; } r -= 2 * I_HU;
        if (r < 2 * I_WO) { const int l = r / I_WO; tr_plain(CIN(10) + (size_t)l * D * D, D, D, WSP(bf16_t, WS_WOUT) + (size_t)l * D * D, D, 0, r % I_WO, scr, C.lane); continue; } r -= 2 * I_WO;
        if (r < I_GU) { tr_gu(CIN(12), DFF0, 0, WSP(bf16_t, WS_DGU), r, scr, C.lane); continue; } r -= I_GU;
        if (r < I_GU) { tr_gu(CIN(13), DFF0, 1, WSP(bf16_t, WS_DGU), r, scr, C.lane); continue; } r -= I_GU;
        if (r < I_DN) { tr_plain(CIN(14), DFF0, D, WSP(bf16_t, WS_DDN), DFF0, 0, r, scr, C.lane); continue; } r -= I_DN;
        { const int l = r / I_G8, q = r % I_G8, nblk = NGATE / 32, kb = q / nblk, nb = q % nblk;
          tr_item8(CIN(2) + (size_t)l * D * INC, INC, 64 * kb, (INC - NGATE) + 32 * nb, C_WS + WS_WG8 + (size_t)l * NGATE * D + (size_t)(32 * nb) * D + 64 * kb, D, F8_W, scr, C.lane); }
    }
    for (int it = gw; it < 2 * 4 * 16 * 16; it += NGW) {
        const int nb = it & 15, kb = (it >> 4) & 15, g = (it >> 8) & 3, l = it >> 10;
        const float* pw = CIN(4) + ((size_t)l * PW + g * 128 + kb * 8) * 128; const float* ps = CIN(5) + l * PW + g * 128; const float* pu = CIN(6) + ((size_t)l * PW + g * 128) * D + nb * 64 + C.lane;
        float acc8[8];
#pragma unroll
        for (int j = 0; j < 8; ++j) acc8[j] = 0.f;
#pragma unroll 8
        for (int d = 0; d < 128; ++d) { const float x = ps[d] * pu[(size_t)d * D];
#pragma unroll
            for (int j = 0; j < 8; ++j) acc8[j] += pw[j * 128 + d] * x; }
        u32x4 o; o.x = cvt_pk_bf16(acc8[0], acc8[1]); o.y = cvt_pk_bf16(acc8[2], acc8[3]); o.z = cvt_pk_bf16(acc8[4], acc8[5]); o.w = cvt_pk_bf16(acc8[6], acc8[7]);
        *(u32x4*)(WSP(bf16_t, WS_WU) + (size_t)l * D * D + (size_t)(nb * 64 + C.lane) * D + g * 128 + kb * 8) = o;
    }
    if (C_BID == 0) { float* lbv = SMP(float, SM_LB);
        for (int c = C.tid; c < HW; c += NT) { const float b0 = CIN(7)[c], b1 = CIN(7)[HW + c], mx = fmaxf(b0, b1), e0 = expf(b0 - mx), e1 = expf(b1 - mx), s0 = e0 / (e0 + e1), s1 = e1 / (e0 + e1);
            lbv[c] = 0.f; lbv[HW + c] = fminf(fmaxf((s0 + s1) - s0, 0.f), 1.0f - 1e-6f); } }
}
__device__ __forceinline__ void phase_moe_weights(Ctx& C) {
    LAS float* scr = (LAS float*)(C.lds + C.wave * 16384);
    const int gw = C_BID * NW + C.wave, NGW = C_G * NW;
    constexpr int I_GU = (D / 64) * (DFF1 / 32), I_DN = (DFF1 / 64) * (D / 32);
    for (int it = gw; it < NEXP * (2 * I_GU + I_DN); it += NGW) {
        const int e = it / (2 * I_GU + I_DN); int r = it % (2 * I_GU + I_DN);
        if (r < 2 * I_GU) { const int isup = r >= I_GU ? 1 : 0; r -= isup * I_GU; const int nblk = DFF1 / 32, kb = r / nblk, nb = r % nblk, n0 = 32 * nb, drow = 256 * (n0 >> 7) + 128 * isup + (n0 & 127);
            tr_item8(CIN(16 + isup) + (size_t)e * D * DFF1, DFF1, 64 * kb, n0, C_WS + WS_MW + e * MW_GU_E + (size_t)drow * D + 64 * kb, D, F8_W, scr, C.lane); continue; }
        r -= 2 * I_GU;
        { const int nblk = D / 32, kb = r / nblk, nb = r % nblk;
          tr_item8(CIN(18) + (size_t)e * DFF1 * D, D, 64 * kb, 32 * nb, C_WS + WS_MWD + e * MW_DN_E + (size_t)(32 * nb) * DFF1 + 64 * kb, DFF1, F8_W, scr, C.lane); }
    }
}

__device__ __forceinline__ void phase_norm(Ctx& C, const float* xsrc, float* xdst, const float* w, bf16_t* hout, float* fout,
                                           const bf16_t* add, const int* slots, int nadd, const float* router, unsigned char* h8out = nullptr, bool xs16 = false) {
    float eps_ = EPS; asm volatile("" : "+s"(eps_));
    f32x4 wv[4];
#pragma unroll
    for (int j = 0; j < 4; ++j) wv[j] = ((const f32x4*)w)[64 * j + C.lane];
    const int rowb = C_BID * 128 + C.wave * 16;
    for (int i = 0; i < 16; i += 2) {
        f32x4 v[2][4]; u32x2 av[2][4];
        if (xs16) {
#pragma unroll
            for (int r = 0; r < 2; ++r)
#pragma unroll
                for (int j = 0; j < 4; ++j) { const u32x2 t = __builtin_nontemporal_load(XB_ROW(xsrc, rowb + i + r) + 64 * j + C.lane); v[r][j] = (f32x4){bf_lo(t.x), bf_hi(t.x), bf_lo(t.y), bf_hi(t.y)}; }
        } else {
#pragma unroll
            for (int r = 0; r < 2; ++r)
#pragma unroll
                for (int j = 0; j < 4; ++j) v[r][j] = __builtin_nontemporal_load((const f32x4*)(xsrc + (size_t)(rowb + i + r) * D) + C.lane + 64 * j);
        }
        if (nadd) {
#pragma unroll
            for (int r = 0; r < 2; ++r)
#pragma unroll
                for (int j = 0; j < 4; ++j) av[r][j] = __builtin_nontemporal_load((const u32x2*)(add + (size_t)(rowb + i + r) * D) + C.lane + 64 * j);
#pragma unroll
            for (int r = 0; r < 2; ++r)
#pragma unroll
                for (int j = 0; j < 4; ++j) { v[r][j][0] += bf_lo(av[r][j].x); v[r][j][1] += bf_hi(av[r][j].x); v[r][j][2] += bf_lo(av[r][j].y); v[r][j][3] += bf_hi(av[r][j].y); }
        }
#pragma unroll
        for (int r = 0; r < 2; ++r) {
            const int row = rowb + i + r;
            float ss = 0.f;
#pragma unroll
            for (int j = 0; j < 4; ++j) ss += (v[r][j][0] * v[r][j][0] + v[r][j][1] * v[r][j][1]) + (v[r][j][2] * v[r][j][2] + v[r][j][3] * v[r][j][3]);
            const float rs = 1.0f / sqrtf(wave_sum(ss, C.lane) * (1.0f / D) + eps_);
            if (xdst) { u32x2* xo = XB_ROW(xdst, row) + C.lane;
#pragma unroll
                for (int j = 0; j < 4; ++j) { u32x2 t; t.x = cvt_pk_bf16(v[r][j][0], v[r][j][1]); t.y = cvt_pk_bf16(v[r][j][2], v[r][j][3]); __builtin_nontemporal_store(t, xo + 64 * j); } }
#pragma unroll
            for (int j = 0; j < 4; ++j) v[r][j] = v[r][j] * rs * wv[j];
            if (hout) { u32x2* ho = (u32x2*)(hout + (size_t)row * D) + C.lane;
#pragma unroll
                for (int j = 0; j < 4; ++j) { u32x2 t; t.x = cvt_pk_bf16(v[r][j][0], v[r][j][1]); t.y = cvt_pk_bf16(v[r][j][2], v[r][j][3]); ho[64 * j] = t; } }
            if (h8out) { const float lim = f8_limit(); unsigned* h8 = (unsigned*)(h8out + (size_t)row * D) + C.lane;
#pragma unroll
                for (int j = 0; j < 4; ++j) h8[64 * j] = pk4_fp8(v[r][j][0] * F8_H, v[r][j][1] * F8_H, v[r][j][2] * F8_H, v[r][j][3] * F8_H, lim); }
        }
    }
}

constexpr int TAILSLOT = 256 * 256;
__device__ __forceinline__ void phase_norm_router(Ctx& C, float* x, const float* w, const bf16_t* add, unsigned char* h8out, const float* router) {
    LAS float* RL = (LAS float*)C.lds;
    LAS int* cnt8 = (LAS int*)(C.lds + 32768);
    for (int i = C.tid; i < D * NEXP / 4; i += NT) { const int c = i >> 1; ((LAS f32x4*)RL)[(i & 1) * 1024 + (4 * (c >> 8) + (c & 3)) * 64 + ((c & 255) >> 2)] = ((const f32x4*)router)[i]; }
    if (C.tid < 8) cnt8[C.tid] = 0;
    __syncthreads();
    float eps_ = EPS; asm volatile("" : "+s"(eps_));
    f32x4 wv[4];
#pragma unroll
    for (int j = 0; j < 4; ++j) wv[j] = ((const f32x4*)w)[64 * j + C.lane];
    const int row0 = C_BID * 128 + C.wave * 16;
    const bool b0 = C.lane & 1, b1 = C.lane & 2, b2 = C.lane & 4;
    u32x2 xv[4], av[4];
    { const u32x2* xr = XB_ROW(x, row0) + C.lane; const u32x2* p = (const u32x2*)(add + (size_t)row0 * D) + C.lane;
#pragma unroll
      for (int j = 0; j < 4; ++j) { xv[j] = __builtin_nontemporal_load(xr + 64 * j); av[j] = __builtin_nontemporal_load(p + 64 * j); } }
    for (int i = 0; i < 16; ++i) {
        const int row = row0 + i;
        f32x4 v[4];
#pragma unroll
        for (int j = 0; j < 4; ++j) { v[j] = (f32x4){bf_lo(xv[j].x), bf_hi(xv[j].x), bf_lo(xv[j].y), bf_hi(xv[j].y)}; v[j][0] += bf_lo(av[j].x); v[j][1] += bf_hi(av[j].x); v[j][2] += bf_lo(av[j].y); v[j][3] += bf_hi(av[j].y); }
        { const int nrow = row0 + min(i + 1, 15); const u32x2* xr = XB_ROW(x, nrow) + C.lane; const u32x2* p = (const u32x2*)(add + (size_t)nrow * D) + C.lane;
#pragma unroll
          for (int j = 0; j < 4; ++j) { xv[j] = __builtin_nontemporal_load(xr + 64 * j); av[j] = __builtin_nontemporal_load(p + 64 * j); } }
        float ss = 0.f;
#pragma unroll
        for (int j = 0; j < 4; ++j) ss += (v[j][0] * v[j][0] + v[j][1] * v[j][1]) + (v[j][2] * v[j][2] + v[j][3] * v[j][3]);
        const float rs = 1.0f / sqrtf(wave_sum(ss, C.lane) * (1.0f / D) + eps_);
        { u32x2* xo = XB_ROW(x, row) + C.lane;
#pragma unroll
          for (int j = 0; j < 4; ++j) { u32x2 t; t.x = cvt_pk_bf16(v[j][0], v[j][1]); t.y = cvt_pk_bf16(v[j][2], v[j][3]); __builtin_nontemporal_store(t, xo + 64 * j); } }
#pragma unroll
        for (int j = 0; j < 4; ++j) v[j] = v[j] * rs * wv[j];
        { const float lim = f8_limit(); unsigned* h8 = (unsigned*)(h8out + (size_t)row * D) + C.lane;
#pragma unroll
          for (int j = 0; j < 4; ++j) h8[64 * j] = pk4_fp8(v[j][0] * F8_H, v[j][1] * F8_H, v[j][2] * F8_H, v[j][3] * F8_H, lim); }
        f32x2 lg[4];
#pragma unroll
        for (int e = 0; e < 4; ++e) lg[e] = (f32x2){0.f, 0.f};
#pragma unroll
        for (int j = 0; j < 4; ++j)
#pragma unroll
            for (int q = 0; q < 4; ++q) { const LAS f32x4* rp = (const LAS f32x4*)RL + (4 * j + q) * 64 + C.lane; const f32x4 r0 = rp[0], r1 = rp[1024]; const f32x2 hv = (f32x2){v[j][q], v[j][q]};
                lg[0] = __builtin_elementwise_fma(hv, (f32x2){r0[0], r0[1]}, lg[0]); lg[1] = __builtin_elementwise_fma(hv, (f32x2){r0[2], r0[3]}, lg[1]);
                lg[2] = __builtin_elementwise_fma(hv, (f32x2){r1[0], r1[1]}, lg[2]); lg[3] = __builtin_elementwise_fma(hv, (f32x2){r1[2], r1[3]}, lg[3]); }
        float t4[4], t2[2], t1;
        { const float a[8] = {lg[0][0], lg[0][1], lg[1][0], lg[1][1], lg[2][0], lg[2][1], lg[3][0], lg[3][1]};
#pragma unroll
          for (int k = 0; k < 4; ++k) { const float send = b0 ? a[k] : a[k + 4], keep = b0 ? a[k + 4] : a[k]; t4[k] = keep + shfl_xor_l(send, 1, C.lane); } }
#pragma unroll
        for (int k = 0; k < 2; ++k) { const float send = b1 ? t4[k] : t4[k + 2], keep = b1 ? t4[k + 2] : t4[k]; t2[k] = keep + shfl_xor_l(send, 2, C.lane); }
        { const float send = b2 ? t2[0] : t2[1], keep = b2 ? t2[1] : t2[0]; t1 = keep + shfl_xor_l(send, 4, C.lane); }
        t1 += shfl_xor_l(t1, 8, C.lane); t1 += shfl_xor_l(t1, 16, C.lane); t1 += shfl_xor_l(t1, 32, C.lane);
        float lt[8];
#pragma unroll
        for (int e = 0; e < 8; ++e) lt[e] = __builtin_bit_cast(float, __builtin_amdgcn_readlane(__builtin_bit_cast(int, t1), ((e >> 2) & 1) | (((e >> 1) & 1) << 1) | ((e & 1) << 2)));
        int e1 = 0; float v1 = lt[0];
#pragma unroll
        for (int e = 1; e < 8; ++e) if (lt[e] > v1) { v1 = lt[e]; e1 = e; }
        int e2 = -1; float v2 = -3.0e38f;
#pragma unroll
        for (int e = 0; e < 8; ++e) if (e != e1 && lt[e] > v2) { v2 = lt[e]; e2 = e; }
        const float ex = expf(v2 - v1), w1 = 1.0f / (1.0f + ex), w2 = ex / (1.0f + ex);
        if (C.lane == 0) { SMP(int, SM_TOKE)[row] = e1 | (e2 << 8); SMP(f32x2, SM_TOKW)[row] = (f32x2){w1, w2}; atomicAdd((int*)cnt8 + e1, 1); atomicAdd((int*)cnt8 + e2, 1); }
    }
    __syncthreads();
    if (C.tid < 8) SMP(int, SM_CNTWG)[C_BID * 8 + C.tid] = cnt8[C.tid];
}
__device__ __forceinline__ void phase_final(Ctx& C, int mode, int nskip) {
    const int vb = C_BID - nskip, nwk = C_G - nskip; if (vb < 0) return;
    const float* w = CIN(19); float* xo = C_OUT; const bf16_t* dn = WSP(bf16_t, WS_DN1); const int* slots = SMP(int, SM_TOKS);
    float eps_ = EPS; asm volatile("" : "+s"(eps_));
    f32x4 wv[4];
#pragma unroll
    for (int j = 0; j < 4; ++j) wv[j] = ((const f32x4*)w)[64 * j + C.lane];
    for (int row = vb * NW + C.wave; row < M; row += nwk * NW) {
        const int s1 = slots[2 * row], s2 = slots[2 * row + 1];
        const bool tail = (s1 >= TAILSLOT) || (s2 >= TAILSLOT);
        if ((mode == 1) == tail) continue;
        f32x4* xr = (f32x4*)(xo + (size_t)row * D) + C.lane; const u32x2* p1 = (const u32x2*)(dn + (size_t)s1 * D) + C.lane; const u32x2* p2_ = (const u32x2*)(dn + (size_t)s2 * D) + C.lane;
        f32x4 v[4]; u32x2 a[4], b[4];
#pragma unroll
        for (int j = 0; j < 4; ++j) { const u32x2 t = __builtin_nontemporal_load(XB_ROW(xo, row) + 64 * j + C.lane); v[j] = (f32x4){bf_lo(t.x), bf_hi(t.x), bf_lo(t.y), bf_hi(t.y)}; a[j] = __builtin_nontemporal_load(p1 + 64 * j); b[j] = __builtin_nontemporal_load(p2_ + 64 * j); }
        float ss = 0.f;
#pragma unroll
        for (int j = 0; j < 4; ++j) { v[j][0] += bf_lo(a[j].x) + bf_lo(b[j].x); v[j][1] += bf_hi(a[j].x) + bf_hi(b[j].x); v[j][2] += bf_lo(a[j].y) + bf_lo(b[j].y); v[j][3] += bf_hi(a[j].y) + bf_hi(b[j].y);
            ss += (v[j][0] * v[j][0] + v[j][1] * v[j][1]) + (v[j][2] * v[j][2] + v[j][3] * v[j][3]); }
        const float rs = 1.0f / sqrtf(wave_sum(ss, C.lane) * (1.0f / D) + eps_);
#pragma unroll
        for (int j = 0; j < 4; ++j) __builtin_nontemporal_store(v[j] * rs * wv[j], xr + 64 * j);
    }
}
__device__ __forceinline__ void phase_route(Ctx& C) {
    LAS int* tot = (LAS int*)C.lds; LAS int* bef = tot + 8; LAS int* base = tot + 16;
    const int* cw = SMP(int, SM_CNTWG);
    { LAS int* pt = tot + 32; LAS int* pb = pt + 512; const int e = C.tid & 7, part = C.tid >> 3; int t = 0, b = 0;
#pragma unroll
      for (int q = 0; q < 4; ++q) { const int g = part * 4 + q; const int c = (g < C_G) ? cw[g * 8 + e] : 0; t += c; b += (g < C_BID) ? c : 0; }
      pt[C.tid] = t; pb[C.tid] = b; }
    __syncthreads();
    if (C.tid < 8) { LAS int* pt = tot + 32; LAS int* pb = pt + 512; int t = 0, b = 0;
#pragma unroll 8
        for (int p = 0; p < 64; ++p) { t += pt[p * 8 + C.tid]; b += pb[p * 8 + C.tid]; }
        tot[C.tid] = t; bef[C.tid] = b; }
    __syncthreads();
    if (C.tid == 0) { int s = 0; for (int e = 0; e < 8; ++e) { base[e] = s; s += ((tot[e] + 255) >> 8) << 8; } base[8] = s; }
    __syncthreads();
    int* rowidx = SMP(int, SM_ROWIDX); float* rowsc = SMP(float, SM_ROWSC);
    if (C_BID == 0) { const int ntiles = base[8] >> 8;
        for (int t = C.tid; t < MAXT; t += NT) { int e = 0; for (int q = 1; q < 8; ++q) e += (base[q] <= t * 256) ? 1 : 0; SMP(int, SM_TILEEXP)[t] = (t < ntiles) ? e : 0; }
        if (C.tid == 0) SMP(int, SM_NT)[0] = ntiles; }
    if (C_BID < 8) { const int e = C_BID; for (int s = base[e] + tot[e] + C.tid; s < base[e + 1]; s += NT) { rowidx[s] = 0; rowsc[s] = 0.f; } }
    if (C.wave == 0) {
        int run[8];
#pragma unroll
        for (int e = 0; e < 8; ++e) run[e] = base[e] + bef[e];
        for (int p = 0; p < 2; ++p) {
            const int tok = C_BID * 128 + p * 64 + C.lane; const int ee = SMP(int, SM_TOKE)[tok], e1 = ee & 255, e2 = ee >> 8; const f32x2 tw = SMP(f32x2, SM_TOKW)[tok];
            int s1 = 0, s2 = 0; const unsigned long long below = (1ull << C.lane) - 1ull;
#pragma unroll
            for (int e = 0; e < 8; ++e) { const bool has = (e1 == e) || (e2 == e); const unsigned long long m = __ballot(has); const int pos = run[e] + __popcll(m & below);
                if (e1 == e) s1 = pos; if (e2 == e) s2 = pos; run[e] += __popcll(m); }
            rowidx[s1] = tok; rowsc[s1] = tw.x; rowidx[s2] = tok; rowsc[s2] = tw.y; SMP(int, SM_TOKS)[2 * tok] = s1; SMP(int, SM_TOKS)[2 * tok + 1] = s2;
        }
    }
}
__device__ __forceinline__ void phase_gather(Ctx& C) {
    const int nslots = __hip_atomic_load(SMP(int, SM_NT), __ATOMIC_RELAXED, __HIP_MEMORY_SCOPE_AGENT) * 256; const int* rowidx = SMP(int, SM_ROWIDX);
    const int s0 = C_BID * NW + C.wave, stride = C_G * NW;
    static_assert(MAXSLOTS <= 64 * 256 * 8, "one lane per trip");
    int myidx = -1; { const int s = s0 + C.lane * stride; if (s < nslots) myidx = rowidx[s]; }
    for (int k = 0; s0 + k * stride < nslots; k += 4) {
        int idx[4]; u32x4 v[4];
#pragma unroll
        for (int j = 0; j < 4; ++j) idx[j] = __builtin_amdgcn_readlane(myidx, k + j);
#pragma unroll
        for (int j = 0; j < 4; ++j) if (idx[j] >= 0) v[j] = *((const u32x4*)(C_WS + WS_H + (size_t)idx[j] * D) + C.lane);
#pragma unroll
        for (int j = 0; j < 4; ++j) if (idx[j] >= 0) *((u32x4*)(C_WS + WS_H2G + (size_t)(s0 + (k + j) * stride) * D) + C.lane) = v[j];
    }
}
__device__ __forceinline__ void phase_pool(Ctx& C) {
    const bf16_t* U = WSP(bf16_t, WS_U); bf16_t* A2 = WSP(bf16_t, WS_A2);
    const int win = 2 << (C.lane >> 4);
    for (int run = C_BID * NW + C.wave; run < M / 16; run += C_G * NW) {
        const int t0 = run * 16, p0 = t0 & (SEQ - 1);
        u32x4 cu[16], ou[16];
#pragma unroll
        for (int tt = 0; tt < 16; ++tt) cu[tt] = *((const u32x4*)(U + (size_t)(t0 + tt) * PW) + C.lane);
#pragma unroll
        for (int tt = 0; tt < 16; ++tt) { const bool ok = p0 + tt - win + 1 >= 0; ou[tt] = *((const u32x4*)(U + (size_t)(ok ? t0 + tt - win + 1 : t0) * PW) + C.lane); }
        float s[8];
#pragma unroll
        for (int q = 0; q < 8; ++q) s[q] = 0.f;
        u32x4 pr[15];
#pragma unroll
        for (int h = 1; h < 16; ++h) { const bool ok = h < win && p0 - h >= 0; pr[h - 1] = *((const u32x4*)(U + (size_t)(ok ? t0 - h : t0) * PW) + C.lane); }
#pragma unroll
        for (int h = 1; h < 16; ++h) { const bool ok = h < win && p0 - h >= 0; const u32x4 z = (u32x4){0u, 0u, 0u, 0u}; const u32x4 t = ok ? pr[h - 1] : z;
            s[0] += bf_lo(t.x); s[1] += bf_hi(t.x); s[2] += bf_lo(t.y); s[3] += bf_hi(t.y); s[4] += bf_lo(t.z); s[5] += bf_hi(t.z); s[6] += bf_lo(t.w); s[7] += bf_hi(t.w); }
#pragma unroll
        for (int tt = 0; tt < 16; ++tt) {
            const int t = t0 + tt, p = p0 + tt; const u32x4 z = (u32x4){0u, 0u, 0u, 0u}; const u32x4 c4 = cu[tt], o = (p - win + 1 >= 0) ? ou[tt] : z;
            const float c[8] = {bf_lo(c4.x), bf_hi(c4.x), bf_lo(c4.y), bf_hi(c4.y), bf_lo(c4.z), bf_hi(c4.z), bf_lo(c4.w), bf_hi(c4.w)};
#pragma unroll
            for (int q = 0; q < 8; ++q) s[q] += c[q];
            const float inv = 1.0f / (float)((p + 1) < win ? (p + 1) : win);
            u32x4 r; r.x = cvt_pk_bf16(s[0] * inv - c[0], s[1] * inv - c[1]); r.y = cvt_pk_bf16(s[2] * inv - c[2], s[3] * inv - c[3]);
            r.z = cvt_pk_bf16(s[4] * inv - c[4], s[5] * inv - c[5]); r.w = cvt_pk_bf16(s[6] * inv - c[6], s[7] * inv - c[7]);
            *((u32x4*)(A2 + (size_t)t * D) + C.lane) = r;
            s[0] -= bf_lo(o.x); s[1] -= bf_hi(o.x); s[2] -= bf_lo(o.y); s[3] -= bf_hi(o.y); s[4] -= bf_lo(o.z); s[5] -= bf_hi(o.z); s[6] -= bf_lo(o.w); s[7] -= bf_hi(o.w);
        }
    }
}

constexpr int HQ_QT = 0, HQ_KH = 17408, HQ_KT = 34816, HQ_VT = 53248, HQ_ST = 71680, HQ_PP = 106496, HQ_DC = 117760, HQ_ER = 118272, HQ_NS = 118784, HQ_TS = 119296;
constexpr int HQ_OT = 0, OTP = 528;
static_assert(64 * OTP <= HQ_KT, "output staging fits over QT | KH");
constexpr int LD128 = 272, LD64 = 144;
template <bool OUT>
__device__ __forceinline__ void hgrn_item(Ctx& C, int item, const float* nw  ) {
    const int bh = item >> 5, j = item & 31, hh = bh & 3, row0 = (bh >> 2) * SEQ + j * 512;
    const int tid = C.tid, lane = C.lane, w = C.wave, fr = lane & 15, fq = lane >> 4;
    LAS unsigned char* L = C.lds;
    const f32x2* LFp = (const f32x2*)(WSP(float, WS_LF) + hh * 128) + lane; const unsigned* Qp = (const unsigned*)(WSP(bf16_t, WS_Q) + hh * 128) + lane; const unsigned* Vp = (const unsigned*)(WSP(bf16_t, WS_V) + hh * 128) + lane;
    f32x4 acc[8];
    if (OUT) { const f32x4* si = (const f32x4*)(WSP(float, WS_SI) + (size_t)item * 16384) + tid;
#pragma unroll
        for (int vj = 0; vj < 8; ++vj) acc[vj] = __builtin_nontemporal_load(si + vj * 512);
    } else {
#pragma unroll
        for (int vj = 0; vj < 8; ++vj) acc[vj] = (f32x4){0.f, 0.f, 0.f, 0.f};
    }
    f32x4 nv[4];
    if (OUT) {
#pragma unroll
        for (int i = 0; i < 4; ++i) nv[i] = *(const f32x4*)(nw + 16 * (tid & 7) + 4 * i); }
    f32x2 gtot = (f32x2){0.f, 0.f}; float lim80 = 80.f, eps_ = EPS; asm volatile("" : "+s"(lim80), "+s"(eps_));
    f32x2 lfA[8], lfB[8]; unsigned vvA[8], vvB[8], qvA[8], qvB[8];
#define HG_LD(p_) (OUT ? __builtin_nontemporal_load(p_) : *(p_))
#define HG_ISSUE(LF_, VV_, QV_, cc) do { const int rbn_ = row0 + (cc) * 64 + 8 * w; _Pragma("unroll") for (int t = 0; t < 8; ++t) { LF_[t] = HG_LD(LFp + (size_t)(rbn_ + t) * (HW / 2)); VV_[t] = HG_LD(Vp + (size_t)(rbn_ + t) * (HW / 2)); if (OUT) QV_[t] = HG_LD(Qp + (size_t)(rbn_ + t) * (HW / 2)); } } while (0)
#define HG_ISSUE_T(LF_, VV_, QV_, cc, t) do { const size_t ro_ = (size_t)(row0 + (cc) * 64 + 8 * w + (t)) * (HW / 2); LF_[t] = HG_LD(LFp + ro_); VV_[t] = HG_LD(Vp + ro_); if (OUT) QV_[t] = HG_LD(Qp + ro_); } while (0)
    HG_ISSUE(lfA, vvA, qvA, 0);
    if (!OUT) HG_ISSUE(lfB, vvB, qvB, 1);
    auto chunk = [&](f32x2 (&lf)[8], unsigned (&vv)[8], unsigned (&qv)[8], f32x2 (&lfn)[8], unsigned (&vvn)[8], unsigned (&qvn)[8], const int c) __attribute__((always_inline)) {
        const int m0 = row0 + c * 64;
        f32x2 Lc[8]; { f32x2 run = (f32x2){0.f, 0.f};
#pragma unroll
            for (int t = 0; t < 8; ++t) { run += lf[t]; Lc[t] = run; } }
        ((LAS f32x2*)(L + HQ_TS))[w * 64 + lane] = Lc[7];
        LDS_BARRIER();
        f32x2 P2 = (f32x2){0.f, 0.f}, P4 = (f32x2){0.f, 0.f}, Pi = (f32x2){0.f, 0.f};
#pragma unroll
        for (int s = 0; s < 8; ++s) { const f32x2 ts = ((LAS f32x2*)(L + HQ_TS))[s * 64 + lane]; P4 += ts; if (s < 4) P2 += ts; if (s < w) Pi += ts; }
        if (w == 0) { ((LAS f32x2*)(L + HQ_DC))[lane] = (f32x2){fast_exp(P4[0]), fast_exp(P4[1])}; ((LAS f32x2*)(L + HQ_ER))[lane] = (f32x2){fast_exp(P2[0]), fast_exp(P2[1])}; gtot += P4; }
        float kt[2][8]; float E42[2] = {0.f, 0.f}; if (OUT) { E42[0] = fast_exp(P4[0] - P2[0]); E42[1] = fast_exp(P4[1] - P2[1]); }
#pragma unroll
        for (int t = 0; t < 8; ++t) {
            float qt2[2], kh2[2];
#pragma unroll
            for (int h = 0; h < 2; ++h) { const float Gt = Pi[h] + Lc[t][h]; const float kk = 1.0f - fast_exp(lf[t][h]);
                const float a = __builtin_amdgcn_fmed3f(Gt - P2[h], -lim80, lim80);
                if (OUT) { const float qf = h ? bf_hi(qv[t]) : bf_lo(qv[t]); qt2[h] = qf * fast_exp(a); kh2[h] = kk * fast_exp(-a); kt[h][t] = kh2[h] * E42[h]; }
                else kt[h][t] = kk * fast_exp(P4[h] - Gt); }
            if (OUT) { const int trow = 8 * w + t;
                *(LAS unsigned*)(L + HQ_QT + trow * LD128 + lane * 4) = cvt_pk_bf16(qt2[0], qt2[1]);
                *(LAS unsigned*)(L + HQ_KH + trow * LD128 + lane * 4) = cvt_pk_bf16(kh2[0], kh2[1]); }
        }
#pragma unroll
        for (int h = 0; h < 2; ++h) {
            *(LAS u32x4*)(L + HQ_KT + (2 * lane + h) * LD64 + w * 16) = (u32x4){cvt_pk_bf16(kt[h][0], kt[h][1]), cvt_pk_bf16(kt[h][2], kt[h][3]), cvt_pk_bf16(kt[h][4], kt[h][5]), cvt_pk_bf16(kt[h][6], kt[h][7])};
            u32x4 vo;
#pragma unroll
            for (int t2 = 0; t2 < 4; ++t2) vo[t2] = h ? ((vv[2 * t2] >> 16) | (vv[2 * t2 + 1] & 0xffff0000u)) : ((vv[2 * t2] & 0xffffu) | (vv[2 * t2 + 1] << 16));
            *(LAS u32x4*)(L + HQ_VT + (2 * lane + h) * LD64 + w * 16) = vo; }
        LDS_BARRIER();
        bf16x8 aq[4]; u32x4 gw0, gw1;
        const int ti = w >> 1;
        if (OUT) {
            const f32x4 er = *(const LAS f32x4*)(L + HQ_ER + (16 * w + 4 * fq) * 4);
#pragma unroll
            for (int vj = 0; vj < 8; ++vj) { u32x2 p; p.x = cvt_pk_bf16(acc[vj][0] * er[0], acc[vj][1] * er[1]); p.y = cvt_pk_bf16(acc[vj][2] * er[2], acc[vj][3] * er[3]);
                *(LAS u32x2*)(L + HQ_ST + (16 * vj + fr) * LD128 + (16 * w + 4 * fq) * 2) = p; }
#pragma unroll
            for (int k2 = 0; k2 < 4; ++k2) aq[k2] = *(const LAS bf16x8*)(L + HQ_QT + (16 * ti + fr) * LD128 + (32 * k2 + 8 * fq) * 2);
#pragma unroll
            for (int q = 0; q < 2; ++q) { const int tj = 2 * (w & 1) + q; f32x4 sc = (f32x4){0.f, 0.f, 0.f, 0.f};
#pragma unroll
                for (int k2 = 0; k2 < 4; ++k2) { const bf16x8 bk = *(const LAS bf16x8*)(L + HQ_KH + (16 * tj + fr) * LD128 + (32 * k2 + 8 * fq) * 2); sc = __builtin_amdgcn_mfma_f32_16x16x32_bf16(aq[k2], bk, sc, 0, 0, 0); }
#pragma unroll
                for (int r = 0; r < 4; ++r) { const int t = 16 * ti + 4 * fq + r, s = 16 * tj + fr; const float pv = (s <= t) ? sc[r] : 0.f;
                    *(LAS bf16_t*)(L + HQ_PP + t * LD64 + s * 2) = (bf16_t)(cvt_pk_bf16(pv, 0.f) & 0xffffu); } }
            { const bf16_t* gp = WSP(bf16_t, WS_GG) + (size_t)(m0 + (tid >> 3)) * HW + hh * 128 + 16 * (tid & 7); gw0 = __builtin_nontemporal_load((const u32x4*)gp); gw1 = __builtin_nontemporal_load((const u32x4*)(gp + 8)); }
            LDS_BARRIER();
            const int cn = min(c + 1, 7);
            bf16x8 ap[2];
#pragma unroll
            for (int k2 = 0; k2 < 2; ++k2) ap[k2] = *(const LAS bf16x8*)(L + HQ_PP + (16 * ti + fr) * LD64 + (32 * k2 + 8 * fq) * 2);
            float ss[4] = {0.f, 0.f, 0.f, 0.f};
#pragma unroll
            for (int q = 0; q < 4; ++q) { const int vj = 4 * (w & 1) + q; f32x4 ov = (f32x4){0.f, 0.f, 0.f, 0.f};
#pragma unroll
                for (int k2 = 0; k2 < 2; ++k2) { const bf16x8 bv = *(const LAS bf16x8*)(L + HQ_VT + (16 * vj + fr) * LD64 + (32 * k2 + 8 * fq) * 2); ov = __builtin_amdgcn_mfma_f32_16x16x32_bf16(ap[k2], bv, ov, 0, 0, 0); }
#pragma unroll
                for (int k2 = 0; k2 < 4; ++k2) { const bf16x8 bs = *(const LAS bf16x8*)(L + HQ_ST + (16 * vj + fr) * LD128 + (32 * k2 + 8 * fq) * 2); ov = __builtin_amdgcn_mfma_f32_16x16x32_bf16(aq[k2], bs, ov, 0, 0, 0); }
#pragma unroll
                for (int r = 0; r < 4; ++r) { *(LAS float*)(L + HQ_OT + (16 * ti + 4 * fq + r) * OTP + (16 * vj + fr) * 4) = ov[r]; ss[r] += ov[r] * ov[r]; }
                HG_ISSUE_T(lfn, vvn, qvn, cn, 2 * q); HG_ISSUE_T(lfn, vvn, qvn, cn, 2 * q + 1); __builtin_amdgcn_sched_barrier(0); }
#pragma unroll
            for (int r = 0; r < 4; ++r) { float s = ss[r]; s += row_ror<1>(s); s += row_ror<2>(s); s += row_ror<4>(s); s += row_ror<8>(s);
                if (fr == 0) ((LAS float*)(L + HQ_NS))[(16 * ti + 4 * fq + r) * 2 + (w & 1)] = s; }
        }
        {
            bf16x8 ak[2];
#pragma unroll
            for (int k2 = 0; k2 < 2; ++k2) ak[k2] = *(const LAS bf16x8*)(L + HQ_KT + (16 * w + fr) * LD64 + (32 * k2 + 8 * fq) * 2);
            const f32x4 dc = *(const LAS f32x4*)(L + HQ_DC + (16 * w + 4 * fq) * 4);
#pragma unroll
            for (int vj = 0; vj < 8; ++vj) { f32x4 a = acc[vj] * dc;
#pragma unroll
                for (int k2 = 0; k2 < 2; ++k2) { const bf16x8 bv = *(const LAS bf16x8*)(L + HQ_VT + (16 * vj + fr) * LD64 + (32 * k2 + 8 * fq) * 2); a = __builtin_amdgcn_mfma_f32_16x16x32_bf16(ak[k2], bv, a, 0, 0, 0); }
                acc[vj] = a;
                if (!OUT) { HG_ISSUE_T(lf, vv, qv, min(c + 2, 7), vj); __builtin_amdgcn_sched_barrier(0); } }
        }
        LDS_BARRIER();
        if (OUT) {
            { const int t = tid >> 3, v0 = 16 * (tid & 7);
              const float tot = ((LAS float*)(L + HQ_NS))[t * 2] + ((LAS float*)(L + HQ_NS))[t * 2 + 1]; const float rs = 1.0f / sqrtf(tot * (1.0f / 128.0f) + eps_);
              f32x4 ox[4];
#pragma unroll
              for (int i = 0; i < 4; ++i) ox[i] = *(const LAS f32x4*)(L + HQ_OT + t * OTP + (v0 + 4 * i) * 4);
              const float g[16] = {bf_lo(gw0.x), bf_hi(gw0.x), bf_lo(gw0.y), bf_hi(gw0.y), bf_lo(gw0.z), bf_hi(gw0.z), bf_lo(gw0.w), bf_hi(gw0.w), bf_lo(gw1.x), bf_hi(gw1.x), bf_lo(gw1.y), bf_hi(gw1.y), bf_lo(gw1.z), bf_hi(gw1.z), bf_lo(gw1.w), bf_hi(gw1.w)};
              float y[16];
#pragma unroll
              for (int i = 0; i < 4; ++i)
#pragma unroll
                  for (int e = 0; e < 4; ++e) y[4 * i + e] = ox[i][e] * rs * nv[i][e] * g[4 * i + e];
              u32x4 w0, w1; w0.x = cvt_pk_bf16(y[0], y[1]); w0.y = cvt_pk_bf16(y[2], y[3]); w0.z = cvt_pk_bf16(y[4], y[5]); w0.w = cvt_pk_bf16(y[6], y[7]);
              w1.x = cvt_pk_bf16(y[8], y[9]); w1.y = cvt_pk_bf16(y[10], y[11]); w1.z = cvt_pk_bf16(y[12], y[13]); w1.w = cvt_pk_bf16(y[14], y[15]);
              bf16_t* op = WSP(bf16_t, WS_A2) + (size_t)(m0 + t) * D + 512 + hh * 128 + v0; *(u32x4*)op = w0; *(u32x4*)(op + 8) = w1; }
        }
    };
    if (OUT) { for (int c = 0; c < 8; ++c) chunk(lfA, vvA, qvA, lfA, vvA, qvA, c); }
    else { for (int c = 0; c < 8; c += 2) { chunk(lfA, vvA, qvA, lfB, vvB, qvB, c); chunk(lfB, vvB, qvB, lfA, vvA, qvA, c + 1); } }
#undef HG_ISSUE
#undef HG_ISSUE_T
#undef HG_LD
    if (!OUT) { f32x4* sl = (f32x4*)(WSP(float, WS_SL) + (size_t)item * 16384) + tid;
#pragma unroll
        for (int vj = 0; vj < 8; ++vj) sl[vj * 512] = acc[vj];
        if (w == 0) SMP(f32x2, SM_DT)[item * 64 + lane] = (f32x2){fast_exp(gtot[0]), fast_exp(gtot[1])}; }
}
__device__ __forceinline__ void phase_scan(Ctx& C) {
    const f32x2* SL = (const f32x2*)WSP(float, WS_SL); f32x2* SI = (f32x2*)WSP(float, WS_SI); const float* DT = SMP(float, SM_DT);
    if (C.tid < 256) {
        const int gid = C_BID * 256 + C.tid, bh = gid >> 13, e2 = gid & 8191, t = (e2 >> 1) & 511, k0 = 16 * (t >> 6) + 4 * ((t >> 4) & 3) + 2 * (e2 & 1);
        f32x2 s = (f32x2){0.f, 0.f};
        f32x2 sl[31], dt[31];
#pragma unroll
        for (int j = 0; j < 31; ++j) { const size_t it = (size_t)(bh * 32 + j); sl[j] = __builtin_nontemporal_load(SL + it * 8192 + e2); dt[j] = *(const f32x2*)(DT + it * 128 + k0); }
#pragma unroll
        for (int j = 0; j < 32; ++j) { SI[(size_t)(bh * 32 + j) * 8192 + e2] = s; if (j < 31) s = dt[j] * s + sl[j]; }
    }
}

constexpr int NSTAGES = 26;

__global__ void __launch_bounds__(NT, 2) fwd(Args a) {
    extern __shared__ __attribute__((aligned(16))) unsigned char lds_raw[];
    Ctx C;
    C.lds = (LAS unsigned char*)lds_raw; C.tid = threadIdx.x; C.lane = C.tid & 63; C.wave = __builtin_amdgcn_readfirstlane(C.tid >> 6);
    int wave_s = C.wave;
    C.a = (const CAS Args*)__builtin_amdgcn_kernarg_segment_ptr();
    volatile LAS unsigned* MISC = (volatile LAS unsigned*)(C.lds + MISC_OFF);
    if (C.tid < 64) MISC[C.tid] = 0u;
    __syncthreads();
#if N_LAUNCHES == 1
    const int lo = 0, hi = NSTAGES;
    (void)xcd_barrier_post((unsigned*)(C_WS + WS_CTL) + CW_BAR, MISC + 8, C.tid);
#define SEAM() do { if (st + 1 < NSTAGES) { XcdBarrier bar_; bar_.bar = (unsigned*)(C_WS + WS_CTL) + CW_BAR; bar_.x = xb_xcc_id(); bar_.st = (volatile LAS unsigned*)(C.lds + MISC_OFF) + 8; unsigned mb_ = ~0u; asm volatile("" : "+s"(mb_), "+s"(wave_s)); const int tid_b = wave_s * 64 + (int)__builtin_amdgcn_mbcnt_hi(mb_, __builtin_amdgcn_mbcnt_lo(mb_, 0u)); xcd_barrier(bar_, tid_b); } } while (0)
#else
    const int lo = C.a->lo, hi = C.a->hi;
#define SEAM() do { } while (0)
#endif
    int st = 0;
#define STAGE_BEGIN(k) if (st >= lo && st < hi) { { unsigned m_ = ~0u; asm volatile("" : "+s"(m_), "+s"(wave_s)); C.lane = (int)__builtin_amdgcn_mbcnt_hi(m_, __builtin_amdgcn_mbcnt_lo(m_, 0u)); C.wave = wave_s; C.tid = wave_s * 64 + C.lane; } asm volatile("" : "+s"(C.a)); asm volatile("" : "+s"(C.lds)); C.G = gridDim.x; C.bid = blockIdx.x; asm volatile("" : "+s"(C.G), "+s"(C.bid));
#define STAGE_END } if (st >= lo && st < hi) { SEAM(); } ++st;
#define Hb WSP(bf16_t, WS_H)
    constexpr unsigned T1K = 256u * 1024 * 2;


    for (int l = 0; l < 2; ++l) {
        STAGE_BEGIN(1) if (l == 0) { phase_prologue(C); }
            phase_norm(C, l == 0 ? CIN(0) : C_OUT, l == 0 ? nullptr : C_OUT, CIN(1) + l * D, Hb, nullptr, WSP(bf16_t, WS_DN0), nullptr, l, nullptr, C_WS + WS_H8, l != 0); STAGE_END
        STAGE_BEGIN(2) {
            {
                pg8::Gemm g{(const char*)C_WS, D, D, D};
                GridOrder S{(unsigned)WS_H, (unsigned)WS_WIN + (unsigned)l * (INC * D * 2), T1K, T1K, M / 256, (INC - NGATE) / 256, C_G, C_BID};
                EpiIn E{C_WS, CIN(3) + l * NGATE, l};
                pg8::gemm_phase<false>(C.lds, g, S, E, C.tid);
            }
            {
                pg8::Gemm g{(const char*)C_WS, D / 2, D / 2, D / 2};
                GridOrder S{(unsigned)WS_H8, (unsigned)WS_WG8 + (unsigned)l * (NGATE * D), 256u * D, 256u * D, M / 256, NGATE / 256, C_G, C_BID};
                EpiGate8 E{C_WS, CIN(3) + l * NGATE, 1.0f / (F8_H * F8_W)};
                pg8::gemm_phase<true>(C.lds, g, S, E, C.tid);
            }
        } STAGE_END
        STAGE_BEGIN(3) phase_pool(C); for (int it = C_BID; it < 256; it += C_G) hgrn_item<false>(C, it, nullptr); STAGE_END
        STAGE_BEGIN(4) phase_scan(C); STAGE_END
        STAGE_BEGIN(5) for (int it = C_BID; it < 256; it += C_G) hgrn_item<true>(C, it, CIN(8) + l * 128); STAGE_END
        STAGE_BEGIN(6) {
            pg8::Gemm g{(const char*)C_WS, D, D, 512};
            UOrder S{(unsigned)WS_A2, (unsigned)WS_WU + (unsigned)l * (D * D * 2), C_G, C_BID};
            EpiU E{C_WS};
            pg8::gemm_phase<false>(C.lds, g, S, E, C.tid);
        } STAGE_END
        STAGE_BEGIN(7) {
            pg8::Gemm g{(const char*)C_WS, D, D, D};
            GridOrder S{(unsigned)WS_H, (unsigned)WS_WOUT + (unsigned)l * (D * D * 2), T1K, T1K, M / 256, D / 256, C_G, C_BID};
            EpiRow E{WSP(bf16_t, WS_MO), D, nullptr, 1.0f};
            pg8::gemm_phase<false>(C.lds, g, S, E, C.tid);
        } STAGE_END
        STAGE_BEGIN(8) if (l == 0) phase_norm(C, CIN(0), C_OUT, CIN(11), Hb, nullptr, WSP(bf16_t, WS_MO), nullptr, 1, nullptr, nullptr);
            else { phase_norm_router(C, C_OUT, CIN(11) + D, WSP(bf16_t, WS_MO), C_WS + WS_H, CIN(15));     __syncthreads(); phase_moe_weights(C); } STAGE_END
        if (l == 1) {
            STAGE_BEGIN(9) phase_route(C); STAGE_END
            STAGE_BEGIN(10) phase_gather(C); STAGE_END
        }
        if (l == 0) {
            STAGE_BEGIN(11) {
                pg8::Gemm g{(const char*)C_WS, D, D, D};
                GuOrder S{(unsigned)WS_H, (unsigned)WS_DGU, nullptr, 0u, T1K, 0, 128, DFF0 / 128, C_G, C_BID};
                EpiSwi E{WSP(bf16_t, WS_ACT0), DFF0};
                pg8::gemm_phase<false>(C.lds, g, S, E, C.tid);
            } STAGE_END
            STAGE_BEGIN(12) {
                pg8::Gemm g{(const char*)C_WS, DFF0, DFF0, DFF0};
                DownOrder S{(unsigned)WS_ACT0, (unsigned)WS_DDN, nullptr, 0u, 256u * DFF0 * 2u, 0, 128, C_G, C_BID};
                EpiRow E{WSP(bf16_t, WS_DN0), D, nullptr, 1.0f};
                pg8::gemm_phase<false>(C.lds, g, S, E, C.tid);
            } STAGE_END
        } else {
            for (int gi = 0; gi < MOE_NG; ++gi) {
#define MOE_PARAMS() const int* texp = SMP(int, SM_TILEEXP); const int ntl = __builtin_amdgcn_readfirstlane(__hip_atomic_load(SMP(int, SM_NT), __ATOMIC_RELAXED, __HIP_MEMORY_SCOPE_AGENT)); \
                const int t0 = gi * MOE_G0; int nT = gi == 0 ? (ntl < MOE_G0 ? ntl : MOE_G0) : (ntl - MOE_G0); nT = nT < 0 ? 0 : nT;
                STAGE_BEGIN(14) {
                    MOE_PARAMS()
                    pg8::Gemm g{(const char*)C_WS, D / 2, D / 2, D / 2};
                    GuOrder S{(unsigned)WS_H2G, (unsigned)WS_MW, texp, (unsigned)MW_GU_E, 256u * D, t0, nT, DFF1 / 128, C_G, C_BID};
                    EpiSwi8 E{C_WS + WS_ACT1, DFF1, 1.0f / (F8_H * F8_W), F8_A};
                    pg8::gemm_phase<true>(C.lds, g, S, E, C.tid);
                } STAGE_END
                STAGE_BEGIN(15) {
                    MOE_PARAMS()
                    const int nTd = nT > 128 ? 128 : nT;
                    pg8::Gemm g{(const char*)C_WS, DFF1 / 2, DFF1 / 2, DFF1 / 2};
                    DownOrder S{(unsigned)WS_ACT1, (unsigned)WS_MWD, texp, (unsigned)MW_DN_E, 256u * DFF1, t0, nTd, C_G, C_BID};
                    EpiRow E{WSP(bf16_t, WS_DN1), D, SMP(float, SM_ROWSC), 1.0f / (F8_A * F8_W)};
                    pg8::gemm_phase<true>(C.lds, g, S, E, C.tid);
                } STAGE_END
            }
        }
    }
    STAGE_BEGIN(16) {
        const int* texp = SMP(int, SM_TILEEXP); const int ntl = __builtin_amdgcn_readfirstlane(__hip_atomic_load(SMP(int, SM_NT), __ATOMIC_RELAXED, __HIP_MEMORY_SCOPE_AGENT));
        const int nTt = ntl > 256 ? ntl - 256 : 0;
        {
            pg8::Gemm g{(const char*)C_WS, DFF1 / 2, DFF1 / 2, DFF1 / 2};
            DownOrder S{(unsigned)WS_ACT1 + 128u * (256u * DFF1), (unsigned)WS_MWD, texp, (unsigned)MW_DN_E, 256u * DFF1, 256, nTt, C_G, C_BID};
            EpiRow E{WSP(bf16_t, WS_DN1), D, SMP(float, SM_ROWSC), 1.0f / (F8_A * F8_W)};
            pg8::gemm_phase<true>(C.lds, g, S, E, C.tid);
        }
        phase_final(C, 1, nTt * 4);
    } STAGE_END
    STAGE_BEGIN(13) phase_final(C, 2, 0); STAGE_END
}


extern "C" void kernel_launch(void* const* d_in, const int* in_sizes, int n_in, void* d_out, int out_size, void* d_ws, size_t ws_size, hipStream_t stream) {
    static int grid = 0;
    if (grid == 0) {
        if (n_in != 20 || in_sizes[0] != M * D || out_size != M * D || ws_size < WS_END) { fprintf(stderr, "kernel_launch: unexpected sizes (n_in %d, out %d, ws %zu < %zu)\n", n_in, out_size, ws_size, (size_t)WS_END); grid = -1; return; }
        int dev = 0, cus = 0;
        if (hipGetDevice(&dev) != hipSuccess || hipDeviceGetAttribute(&cus, hipDeviceAttributeMultiprocessorCount, dev) != hipSuccess) { grid = -1; return; }
        if (hipFuncSetAttribute((const void*)fwd, hipFuncAttributeMaxDynamicSharedMemorySize, LDS_BYTES) != hipSuccess) { fprintf(stderr, "kernel_launch: hipFuncSetAttribute failed\n"); grid = -1; return; }
        int per_cu = 0;
        if (hipOccupancyMaxActiveBlocksPerMultiprocessor(&per_cu, (const void*)fwd, NT, LDS_BYTES) != hipSuccess || per_cu < 1) fprintf(stderr, "kernel_launch: occupancy query reports %d blocks per CU\n", per_cu);
        (void)hipGetLastError();
        if (cus != 256) { fprintf(stderr, "kernel_launch: built for a 256-CU device, found %d\n", cus); grid = -1; return; }
        grid = cus;
    }
    if (grid < 0) return;
    static_assert((CW_BAR + XB_TOPGEN + 64) * 4 <= 32768, "barrier words inside the cleared span");
    if (hipMemsetAsync((char*)d_ws + WS_CTL, 0, 32768, stream) != hipSuccess) return;
    Args a{};
    for (int i = 0; i < 20; ++i) a.in[i] = (const float*)d_in[i];
    a.out = (float*)d_out; a.ws = (unsigned char*)d_ws;
#if N_LAUNCHES == 1
    a.lo = 0; a.hi = NSTAGES;
    hipLaunchKernelGGL(fwd, dim3(grid), dim3(NT), LDS_BYTES, stream, a);
#else
    for (int s = 0; s < NSTAGES; ++s) { a.lo = s; a.hi = s + 1; hipLaunchKernelGGL(fwd, dim3(grid), dim3(NT), LDS_BYTES, stream, a); }

#endif
}
```
